# Optimizing an MI355X kernel written in HIP

```python
import math
import jax, jax.numpy as jnp
from jax import lax
import numpy as np

D_MODEL = 1024
BATCH = 2
SEQ = 8192
DEPTH = 2
DEC_BATCH = 4
DEC_SEQ = 4096
PAST_LEN = 128

HEAD_DIM = 64
A_HEADS = 8
A_KV_HEADS = 2
WINDOW = 128
B_HEADS = 8
B_Q_RANK = 512
B_KV_RANK = 256
B_NOPE = 64
B_ROPE = 32
B_V_DIM = 64
B_QK_DIM = B_NOPE + B_ROPE
C_HEADS = 4
C_V_DIM = 2 * HEAD_DIM
D_HEADS = 8
D_KV_HEADS = 2
D_FF = 2816
GRID_W = 64
ROPE_THETA = 10000.0
NORM_EPS = 1e-6
Q_BLOCK = 128
NEG_INF = -1e30
N_EVEN_LAYERS = (DEPTH + 1) // 2
N_ODD_LAYERS = DEPTH // 2
EV_IN_SIZES = (A_HEADS * HEAD_DIM, A_KV_HEADS * HEAD_DIM, A_KV_HEADS * HEAD_DIM, B_Q_RANK, B_KV_RANK, B_ROPE)
OD_IN_SIZES = (2 * C_HEADS * HEAD_DIM, 2 * C_HEADS * HEAD_DIM, C_HEADS * C_V_DIM, D_HEADS * HEAD_DIM, D_KV_HEADS * HEAD_DIM, D_KV_HEADS * HEAD_DIM)
EV_IN = sum(EV_IN_SIZES)
OD_IN = sum(OD_IN_SIZES)
EV_MIX = A_HEADS * HEAD_DIM + B_HEADS * B_V_DIM
OD_MIX = C_HEADS * C_V_DIM + D_HEADS * HEAD_DIM

kernel_name = 'hybrid_bidir_encoder_swa_mla_diff_axial'


def rms_norm(x, g):
    xf = x.astype(jnp.float32)
    y = xf * lax.rsqrt(jnp.mean(xf * xf, axis=-1, keepdims=True) + NORM_EPS)
    return (y * g.astype(jnp.float32)).astype(x.dtype)


def rope_angles(pos, dim):
    inv = ROPE_THETA ** (-(jnp.arange(0, dim, 2, dtype=jnp.float32) / dim))
    ang = pos.astype(jnp.float32)[:, None] * inv[None, :]
    return jnp.cos(ang), jnp.sin(ang)


def apply_rope(x, cos, sin):
    x1, x2 = jnp.split(x, 2, axis=-1)
    c = cos[:, None, :].astype(x.dtype)
    s = sin[:, None, :].astype(x.dtype)
    return jnp.concatenate([x1 * c - x2 * s, x1 * s + x2 * c], axis=-1)


def apply_axial_rope(x, rope_row, rope_col):
    xr, xc = jnp.split(x, 2, axis=-1)
    return jnp.concatenate([apply_rope(xr, *rope_row), apply_rope(xc, *rope_col)], axis=-1)


def _split_cols(z, sizes):
    offs = np.cumsum(sizes)[:-1].tolist()
    return jnp.split(z, offs, axis=-1)


def _query_blocks(q):
    b, s = q.shape[0], q.shape[1]
    return jnp.moveaxis(q.reshape((b, s // Q_BLOCK, Q_BLOCK) + q.shape[2:]), 1, 0)


def _merge_blocks(o):
    o = jnp.moveaxis(o, 0, 1)
    return o.reshape((o.shape[0], o.shape[1] * o.shape[2]) + o.shape[3:])


def swiglu_ffn(x, g, w_in, w_out):
    gate, up = jnp.split(rms_norm(x, g) @ w_in, 2, axis=-1)
    return (jax.nn.silu(gate) * up) @ w_out


def blocked_attention(q, k, v, scale):
    def one_block(qb):
        sc = jnp.einsum('bqkgd,bjkd->bkgqj', qb, k).astype(jnp.float32) * scale
        pr = jax.nn.softmax(sc, axis=-1).astype(v.dtype)
        return jnp.einsum('bkgqj,bjke->bqkge', pr, v)
    o = _merge_blocks(lax.map(one_block, _query_blocks(q)))
    return o.reshape(o.shape[0], o.shape[1], -1)


def sliding_window_attention_with_sink(q, k, v, sink):
    b, s, hq, d = q.shape
    hk = k.shape[2]
    g = hq // hk
    nb = s // WINDOW
    qb = q.reshape(b, nb, WINDOW, hk, g, d)
    pad = ((0, 0), (WINDOW, WINDOW), (0, 0), (0, 0))

    def band(t):
        tb = jnp.pad(t, pad).reshape(b, nb + 2, WINDOW, hk, d)
        return jnp.concatenate([tb[:, :-2], tb[:, 1:-1], tb[:, 2:]], axis=2)

    kb, vb = band(k), band(v)
    qi = jnp.arange(WINDOW)[:, None]
    kj = jnp.arange(3 * WINDOW)[None, :]
    rel = kj - WINDOW - qi
    kpos = jnp.arange(nb)[:, None] * WINDOW - WINDOW + jnp.arange(3 * WINDOW)[None, :]
    valid = (jnp.abs(rel) <= WINDOW)[None] & ((kpos >= 0) & (kpos < s))[:, None, :]
    sc = jnp.einsum('bnqkgd,bnjkd->bnkgqj', qb, kb).astype(jnp.float32) * (d ** -0.5)
    sc = jnp.where(valid[None, :, None, None], sc, NEG_INF)
    sink_l = jnp.broadcast_to(sink.astype(jnp.float32).reshape(1, 1, hk, g, 1, 1), sc.shape[:-1] + (1,))
    pr = jax.nn.softmax(jnp.concatenate([sc, sink_l], axis=-1), axis=-1)[..., :-1]
    o = jnp.einsum('bnkgqj,bnjkd->bnqkgd', pr.astype(v.dtype), vb)
    return o.reshape(b, s, hq * d)


def differential_attention(q, k, v, lam):
    scale = HEAD_DIM ** -0.5

    def one_block(qb):
        sc = jnp.einsum('bqhcd,bjhcd->bhcqj', qb, k).astype(jnp.float32) * scale
        pm = jax.nn.softmax(sc, axis=-1)
        diff = pm[:, :, 0] - lam * pm[:, :, 1]
        return jnp.einsum('bhqj,bjhe->bqhe', diff.astype(v.dtype), v)
    return _merge_blocks(lax.map(one_block, _query_blocks(q)))


def even_mixer(h, p, i, rope_full, rope_mla):
    b, s, _ = h.shape
    a_q, a_k, a_v, b_cq, b_ckv, b_kr = _split_cols(h @ p['ev_w_in'][i], EV_IN_SIZES)
    qa = apply_rope(rms_norm(a_q.reshape(b, s, A_HEADS, HEAD_DIM), p['a_q_norm'][i]), *rope_full)
    ka = apply_rope(rms_norm(a_k.reshape(b, s, A_KV_HEADS, HEAD_DIM), p['a_k_norm'][i]), *rope_full)
    va = a_v.reshape(b, s, A_KV_HEADS, HEAD_DIM)
    o_a = sliding_window_attention_with_sink(qa, ka, va, p['a_sink'][i])
    qb = (rms_norm(b_cq, p['b_cq_norm'][i]) @ p['b_w_uq'][i]).reshape(b, s, B_HEADS, B_QK_DIM)
    kv = (rms_norm(b_ckv, p['b_ckv_norm'][i]) @ p['b_w_ukv'][i]).reshape(b, s, B_HEADS, B_NOPE + B_V_DIM)
    k_nope, vb = jnp.split(kv, [B_NOPE], axis=-1)
    k_r = jnp.broadcast_to(b_kr[:, :, None, :], (b, s, B_HEADS, B_ROPE))
    kb = jnp.concatenate([k_nope, k_r], axis=-1)
    qb = rms_norm(qb, p['b_q_norm'][i])
    kb = rms_norm(kb, p['b_k_norm'][i])
    qb = jnp.concatenate([qb[..., :B_NOPE], apply_rope(qb[..., B_NOPE:], *rope_mla)], axis=-1)
    kb = jnp.concatenate([kb[..., :B_NOPE], apply_rope(kb[..., B_NOPE:], *rope_mla)], axis=-1)
    o_b = blocked_attention(qb[:, :, :, None, :], kb, vb, B_QK_DIM ** -0.5)
    return jnp.concatenate([o_a, o_b], axis=-1) @ p['ev_w_out'][i]


def odd_mixer(h, p, i, layer, rope_full, rope_row, rope_col):
    b, s, _ = h.shape
    c_q, c_k, c_v, d_q, d_k, d_v = _split_cols(h @ p['od_w_in'][i], OD_IN_SIZES)
    lam_init = 0.8 - 0.6 * math.exp(-0.3 * layer)
    qc = apply_rope(rms_norm(c_q.reshape(b, s, 2 * C_HEADS, HEAD_DIM), p['c_q_norm'][i]), *rope_full)
    kc = apply_rope(rms_norm(c_k.reshape(b, s, 2 * C_HEADS, HEAD_DIM), p['c_k_norm'][i]), *rope_full)
    qc = qc.reshape(b, s, C_HEADS, 2, HEAD_DIM)
    kc = kc.reshape(b, s, C_HEADS, 2, HEAD_DIM)
    vc = c_v.reshape(b, s, C_HEADS, C_V_DIM)
    lp = p['c_lambda'][i].astype(jnp.float32)
    lam = jnp.exp(jnp.sum(lp[0] * lp[1])) - jnp.exp(jnp.sum(lp[2] * lp[3])) + lam_init
    o_c = differential_attention(qc, kc, vc, lam)
    o_c = (rms_norm(o_c, p['c_out_norm'][i]) * (1.0 - lam_init)).reshape(b, s, C_HEADS * C_V_DIM)
    qd = apply_axial_rope(rms_norm(d_q.reshape(b, s, D_HEADS, HEAD_DIM), p['d_q_norm'][i]), rope_row, rope_col)
    kd = apply_axial_rope(rms_norm(d_k.reshape(b, s, D_KV_HEADS, HEAD_DIM), p['d_k_norm'][i]), rope_row, rope_col)
    vd = d_v.reshape(b, s, D_KV_HEADS, HEAD_DIM)
    o_d = blocked_attention(qd.reshape(b, s, D_KV_HEADS, D_HEADS // D_KV_HEADS, HEAD_DIM), kd, vd, HEAD_DIM ** -0.5)
    return jnp.concatenate([o_c, o_d], axis=-1) @ p['od_w_out'][i]


def encoder_trunk(x, p):
    s = x.shape[1]
    rows = s // GRID_W
    pos = jnp.arange(s)
    row = jnp.repeat(jnp.arange(rows), GRID_W)
    col = jnp.tile(jnp.arange(GRID_W), rows)
    rope_full = rope_angles(pos, HEAD_DIM)
    rope_mla = rope_angles(pos, B_ROPE)
    rope_row = rope_angles(row, HEAD_DIM // 2)
    rope_col = rope_angles(col, HEAD_DIM // 2)
    for l in range(DEPTH):
        x = x + 0.5 * swiglu_ffn(x, p['ffn1_norm'][l], p['ffn1_w_in'][l], p['ffn1_w_out'][l])
        if l % 2 == 0:
            i = l // 2
            x = x + even_mixer(rms_norm(x, p['ev_norm'][i]), p, i, rope_full, rope_mla)
        else:
            i = l // 2
            x = x + odd_mixer(rms_norm(x, p['od_norm'][i]), p, i, l, rope_full, rope_row, rope_col)
        x = x + 0.5 * swiglu_ffn(x, p['ffn2_norm'][l], p['ffn2_w_in'][l], p['ffn2_w_out'][l])
    return x


def setup_inputs(seed: int = 0) -> dict:
    key = jax.random.key(seed)
    ks = iter(jax.random.split(key, 32))

    def nrm(shape, scale):
        return jax.random.normal(next(ks), shape, jnp.float32) * scale

    def gain(shape):
        return 1.0 + 0.05 * jax.random.normal(next(ks), shape, jnp.float32)

    L, E, O = DEPTH, N_EVEN_LAYERS, N_ODD_LAYERS
    return {
        'x_prompt': nrm((BATCH, SEQ, D_MODEL), 1.0),
        'x_sample': nrm((DEC_BATCH, DEC_SEQ, D_MODEL), 1.0),
        'ffn1_norm': gain((L, D_MODEL)),
        'ffn1_w_in': nrm((L, D_MODEL, 2 * D_FF), D_MODEL ** -0.5),
        'ffn1_w_out': nrm((L, D_FF, D_MODEL), D_FF ** -0.5),
        'ffn2_norm': gain((L, D_MODEL)),
        'ffn2_w_in': nrm((L, D_MODEL, 2 * D_FF), D_MODEL ** -0.5),
        'ffn2_w_out': nrm((L, D_FF, D_MODEL), D_FF ** -0.5),
        'ev_norm': gain((E, D_MODEL)),
        'ev_w_in': nrm((E, D_MODEL, EV_IN), D_MODEL ** -0.5),
        'a_q_norm': gain((E, HEAD_DIM)),
        'a_k_norm': gain((E, HEAD_DIM)),
        'a_sink': nrm((E, A_HEADS), 0.5),
        'b_cq_norm': gain((E, B_Q_RANK)),
        'b_w_uq': nrm((E, B_Q_RANK, B_HEADS * B_QK_DIM), B_Q_RANK ** -0.5),
        'b_ckv_norm': gain((E, B_KV_RANK)),
        'b_w_ukv': nrm((E, B_KV_RANK, B_HEADS * (B_NOPE + B_V_DIM)), B_KV_RANK ** -0.5),
        'b_q_norm': gain((E, B_QK_DIM)),
        'b_k_norm': gain((E, B_QK_DIM)),
        'ev_w_out': nrm((E, EV_MIX, D_MODEL), EV_MIX ** -0.5),
        'od_norm': gain((O, D_MODEL)),
        'od_w_in': nrm((O, D_MODEL, OD_IN), D_MODEL ** -0.5),
        'c_q_norm': gain((O, HEAD_DIM)),
        'c_k_norm': gain((O, HEAD_DIM)),
        'c_lambda': nrm((O, 4, HEAD_DIM), 0.1),
        'c_out_norm': gain((O, C_V_DIM)),
        'd_q_norm': gain((O, HEAD_DIM)),
        'd_k_norm': gain((O, HEAD_DIM)),
        'od_w_out': nrm((O, OD_MIX, D_MODEL), OD_MIX ** -0.5),
    }


def reference(x_prompt, x_sample, ffn1_norm, ffn1_w_in, ffn1_w_out, ffn2_norm, ffn2_w_in, ffn2_w_out,
              ev_norm, ev_w_in, a_q_norm, a_k_norm, a_sink, b_cq_norm, b_w_uq, b_ckv_norm, b_w_ukv,
              b_q_norm, b_k_norm, ev_w_out, od_norm, od_w_in, c_q_norm, c_k_norm, c_lambda, c_out_norm,
              d_q_norm, d_k_norm, od_w_out):
    p = {
        'ffn1_norm': ffn1_norm, 'ffn1_w_in': ffn1_w_in, 'ffn1_w_out': ffn1_w_out,
        'ffn2_norm': ffn2_norm, 'ffn2_w_in': ffn2_w_in, 'ffn2_w_out': ffn2_w_out,
        'ev_norm': ev_norm, 'ev_w_in': ev_w_in, 'a_q_norm': a_q_norm, 'a_k_norm': a_k_norm,
        'a_sink': a_sink, 'b_cq_norm': b_cq_norm, 'b_w_uq': b_w_uq, 'b_ckv_norm': b_ckv_norm,
        'b_w_ukv': b_w_ukv, 'b_q_norm': b_q_norm, 'b_k_norm': b_k_norm, 'ev_w_out': ev_w_out,
        'od_norm': od_norm, 'od_w_in': od_w_in, 'c_q_norm': c_q_norm, 'c_k_norm': c_k_norm,
        'c_lambda': c_lambda, 'c_out_norm': c_out_norm, 'd_q_norm': d_q_norm, 'd_k_norm': d_k_norm,
        'od_w_out': od_w_out,
    }
    y_prompt = encoder_trunk(x_prompt, p)
    y_sample = encoder_trunk(x_sample, p)
    return (y_prompt, y_sample)
```

```cpp
#include <hip/hip_runtime.h>
#include <hip/hip_cooperative_groups.h>
#include <cstdio>
#include <cstdint>
#include <cmath>
namespace cg = cooperative_groups;
namespace pg8 {
#define PG8_LAS __attribute__((address_space(3)))
typedef unsigned short bf16_t;
typedef short bf16x8 __attribute__((ext_vector_type(8)));
typedef float f32x4 __attribute__((ext_vector_type(4)));
typedef unsigned u32x4 __attribute__((ext_vector_type(4)));
constexpr int BM = 256, BK = 64, HALF = 128, HTB = HALF * BK * 2  , STAGE_BYTES = 8 * HTB, NXCD = 8, WGM = 8;

__host__ __device__ __forceinline__ int lds_byte(int r, int c) { const int st = (r >> 4) * 2 + (c >> 5), rr = r & 15, cc = c & 31, ob = rr * 64 + cc * 2; return st * 1024 + (ob ^ (((ob >> 9) & 1) << 5)); }
__host__ __device__ __forceinline__ void stage_rc(int b, int& R, int& C) { const int st = b / 1024, sb = b % 1024, swz = sb ^ (((sb >> 9) & 1) << 5); R = (st >> 1) * 16 + swz / 64; C = (st & 1) * 32 + (swz % 64) / 2; }
__host__ __device__ __forceinline__ int perm32(int rho) { const int n = rho >> 4, i = rho & 15; return 8 * (i >> 2) + 4 * n + (i & 3); }

struct Unit { int pm, pn; };
struct Gemm { const bf16_t* A; const bf16_t* Bt; int M, N, K, lda, ldb; };

struct StaticOrder {
    int nM, nN, nwg, G, c;
    __host__ __device__ void init(int M, int N, int G_, int c_) { nM = M / BM; nN = N / BM; nwg = nM * nN; G = G_; c = c_; }
    __host__ __device__ bool next(int i, Unit& u) const {
        const long L = (long)i * G + c; if (L >= nwg) return false;
        int wgid = (int)L; { const int q = nwg / NXCD, r = nwg % NXCD, xcd = wgid % NXCD, off = wgid / NXCD; wgid = (xcd < r ? xcd * (q + 1) : r * (q + 1) + (xcd - r) * q) + off; }
        const int nig = WGM * nN, gid = wgid / nig, fm = gid * WGM, gsz = (nM - fm) < WGM ? (nM - fm) : WGM;
        u.pm = fm + ((wgid % nig) % gsz); u.pn = (wgid % nig) / gsz; return true;
    }
    __device__ __forceinline__ void a_ready(const Unit&) const {}
    __device__ __forceinline__ void done(const Unit&) const {}
};


__device__ __forceinline__ unsigned cvt_pk_bf16(float lo, float hi) { unsigned r; asm volatile("v_cvt_pk_bf16_f32 %0, %1, %2" : "=v"(r) : "v"(lo), "v"(hi)); return r; }

struct EpiStore {
    static constexpr bool PERM = true, AFTER_DRAIN = false;
    bf16_t* O; int ldc;
    __device__ __forceinline__ void operator()(const f32x4 (&acc)[2][2][4][2], const Unit& u, int wr, int wc, int fr, int fq) const {
        const int row0 = u.pm * BM + wr * 64 + fr; const int col0 = u.pn * BM + wc * 32 + 8 * fq;
#pragma unroll
        for (int ai = 0; ai < 2; ++ai)
#pragma unroll
            for (int m = 0; m < 4; ++m) { bf16_t* rowp = O + (size_t)(row0 + ai * HALF + m * 16) * ldc + col0;
#pragma unroll
                for (int bj = 0; bj < 2; ++bj) { const f32x4 v0 = acc[ai][bj][m][0], v1 = acc[ai][bj][m][1];
                    u32x4 w; w.x = cvt_pk_bf16(v0[0], v0[1]); w.y = cvt_pk_bf16(v0[2], v0[3]); w.z = cvt_pk_bf16(v1[0], v1[1]); w.w = cvt_pk_bf16(v1[2], v1[3]);
                    *(u32x4*)(rowp + bj * HALF) = w; } }
    }
};
__device__ __forceinline__ float silu_mul(float g, float u) { const float e = __builtin_amdgcn_exp2f(g * -1.4426950408889634f); return g * __builtin_amdgcn_rcpf(1.0f + e) * u; }
struct EpiSwiglu {
    static constexpr bool PERM = true, AFTER_DRAIN = false;
    bf16_t* H; int ldh;
    __device__ __forceinline__ void operator()(const f32x4 (&acc)[2][2][4][2], const Unit& u, int wr, int wc, int fr, int fq) const {
        const int row0 = u.pm * BM + wr * 64 + fr; const int col0 = u.pn * HALF + wc * 32 + 8 * fq;
#pragma unroll
        for (int ai = 0; ai < 2; ++ai)
#pragma unroll
            for (int m = 0; m < 4; ++m) { bf16_t* rowp = H + (size_t)(row0 + ai * HALF + m * 16) * ldh + col0;
                const f32x4 g0 = acc[ai][0][m][0], g1 = acc[ai][0][m][1], u0 = acc[ai][1][m][0], u1 = acc[ai][1][m][1];
                u32x4 w; w.x = cvt_pk_bf16(silu_mul(g0[0], u0[0]), silu_mul(g0[1], u0[1])); w.y = cvt_pk_bf16(silu_mul(g0[2], u0[2]), silu_mul(g0[3], u0[3]));
                w.z = cvt_pk_bf16(silu_mul(g1[0], u1[0]), silu_mul(g1[1], u1[1])); w.w = cvt_pk_bf16(silu_mul(g1[2], u1[2]), silu_mul(g1[3], u1[3]));
                *(u32x4*)rowp = w; }
    }
};
struct EpiResid {
    static constexpr bool PERM = false, AFTER_DRAIN = false;
    const float* base; float* out; int ldc; float scale;
    __device__ __forceinline__ void operator()(const f32x4 (&acc)[2][2][4][2], const Unit& u, int wr, int wc, int fr, int fq) const {
        const int row0 = u.pm * BM + wr * 64 + fr; const int col0 = u.pn * BM + wc * 32 + 4 * fq;
#pragma unroll
        for (int ai = 0; ai < 2; ++ai)
#pragma unroll
            for (int m = 0; m < 4; ++m) { const size_t off = (size_t)(row0 + ai * HALF + m * 16) * ldc + col0;
#pragma unroll
                for (int bj = 0; bj < 2; ++bj)
#pragma unroll
                    for (int n = 0; n < 2; ++n) { const f32x4 b = *(const f32x4*)(base + off + bj * HALF + n * 16); *(f32x4*)(out + off + bj * HALF + n * 16) = b + acc[ai][bj][m][n] * scale; }
                asm volatile("" ::: "memory"); }
    }
};

struct EpiResidNorm {
    static constexpr bool PERM = false, AFTER_DRAIN = true;
    const float* base; float* out; int ldc; float scale; const float* gain; bf16_t* xn; unsigned* xbuf; unsigned* cnt;
    __device__ __forceinline__ void fused(f32x4 (&acc)[2][2][4][2], const Unit& u, int wr, int wc, int fr, int fq, PG8_LAS unsigned char* lds, int wid, int lane) const {
        PG8_LAS float* P = (PG8_LAS float*)lds;
        PG8_LAS float* S = (PG8_LAS float*)(lds + 4096);
        const int col0 = u.pn * BM + wc * 32 + 4 * fq;
#pragma unroll
        for (int ai = 0; ai < 2; ++ai) {
            f32x4 bv[4][2][2];
#pragma unroll
            for (int m = 0; m < 4; ++m) { const size_t off = (size_t)(u.pm * BM + ai * HALF + wr * 64 + m * 16 + fr) * ldc + col0;
#pragma unroll
                for (int bj = 0; bj < 2; ++bj)
#pragma unroll
                    for (int n = 0; n < 2; ++n) bv[m][bj][n] = *(const f32x4*)(base + off + bj * HALF + n * 16); }
            asm volatile("" ::: "memory");
#pragma unroll
            for (int m = 0; m < 4; ++m) { const size_t off = (size_t)(u.pm * BM + ai * HALF + wr * 64 + m * 16 + fr) * ldc + col0; float sq = 0.f;
#pragma unroll
                for (int bj = 0; bj < 2; ++bj)
#pragma unroll
                    for (int n = 0; n < 2; ++n) { const f32x4 v = bv[m][bj][n] + acc[ai][bj][m][n] * scale; acc[ai][bj][m][n] = v;
                        *(f32x4*)(out + off + bj * HALF + n * 16) = v; sq += (v[0] * v[0] + v[1] * v[1]) + (v[2] * v[2] + v[3] * v[3]); }
                sq += __shfl_xor(sq, 16); sq += __shfl_xor(sq, 32);
                if (fq == 0) P[(ai * HALF + wr * 64 + m * 16 + fr) * 4 + wc] = sq; }
            asm volatile("" ::: "memory"); }
        asm volatile("s_waitcnt lgkmcnt(0)" ::: "memory"); __builtin_amdgcn_s_barrier(); asm volatile("" ::: "memory");
        const int row = wid * 32 + (lane & 31);
        if (lane < 32) { const float t = (P[row * 4 + 0] + P[row * 4 + 1]) + (P[row * 4 + 2] + P[row * 4 + 3]);
            __hip_atomic_store(xbuf + ((size_t)(u.pm * BM + row) * 4 + u.pn), __float_as_uint(t), __ATOMIC_RELAXED, __HIP_MEMORY_SCOPE_AGENT); }
        asm volatile("s_waitcnt vmcnt(0)" ::: "memory");
        if (lane == 0) __hip_atomic_fetch_add(cnt + 16 * u.pm, 1u, __ATOMIC_RELAXED, __HIP_MEMORY_SCOPE_AGENT);
        if (wid == 0) {
            unsigned sp = 0;
            while ((unsigned)__builtin_amdgcn_readfirstlane(__hip_atomic_load(cnt + 16 * u.pm, __ATOMIC_RELAXED, __HIP_MEMORY_SCOPE_AGENT)) < 32u) { __builtin_amdgcn_s_sleep(2); if (++sp > (1u << 22)) break; }
            __builtin_amdgcn_fence(__ATOMIC_ACQUIRE, "agent");
        }
        asm volatile("s_waitcnt vmcnt(0) lgkmcnt(0)" ::: "memory"); __builtin_amdgcn_s_barrier(); asm volatile("" ::: "memory");
        if (lane < 32) { const unsigned* slot = xbuf + (size_t)(u.pm * BM + row) * 4; float ss = 0.f;
#pragma unroll
            for (int t = 0; t < 4; ++t) ss += __uint_as_float(__hip_atomic_load(slot + t, __ATOMIC_RELAXED, __HIP_MEMORY_SCOPE_AGENT));
            S[row] = 1.0f / sqrtf(ss * (1.0f / 1024.0f) + 1e-6f); }
        asm volatile("s_waitcnt lgkmcnt(0)" ::: "memory"); __builtin_amdgcn_s_barrier(); asm volatile("" ::: "memory");
        typedef unsigned u32x2v __attribute__((ext_vector_type(2)));
#pragma unroll
        for (int ai = 0; ai < 2; ++ai)
#pragma unroll
            for (int m = 0; m < 4; ++m) { const int r = ai * HALF + wr * 64 + m * 16 + fr; const float rs = S[r]; const size_t off = (size_t)(u.pm * BM + r) * ldc + col0;
#pragma unroll
                for (int bj = 0; bj < 2; ++bj)
#pragma unroll
                    for (int n = 0; n < 2; ++n) { const f32x4 g4 = *(const f32x4*)(gain + col0 + bj * HALF + n * 16); const f32x4 o = acc[ai][bj][m][n] * rs * g4;
                        u32x2v w; w.x = cvt_pk_bf16(o[0], o[1]); w.y = cvt_pk_bf16(o[2], o[3]); *(u32x2v*)(xn + off + bj * HALF + n * 16) = w; } }
    }
};

template <class Epi, class Sched, bool ALIGN_EPI = false, bool SP2 = false>
__device__ __forceinline__ void gemm_phase(PG8_LAS unsigned char* lds, const Gemm g, const Sched& S, const Epi& E) {
    int tid_ = threadIdx.x; asm volatile("" : "+v"(tid_));
    const int tid = tid_, wid = __builtin_amdgcn_readfirstlane(tid >> 6), lane = tid & 63, wr = wid >> 2, wc = wid & 3, fr = lane & 15, fq = lane >> 4;
    const int K = g.K, nt = K / BK;
    unsigned voffA[2], voffB[2];
#pragma unroll
    for (int i = 0; i < 2; ++i) { int R, C; stage_rc(tid * 16 + i * 8192, R, C); const int Rb = Epi::PERM ? ((R & ~31) + perm32(R & 31)) : R;
        voffA[i] = (unsigned)(R * g.lda + C) * 2u; voffB[i] = (unsigned)(Rb * g.ldb + C) * 2u; }
    const size_t kstep = (size_t)(BK * 2);
    const size_t hstepA = (size_t)HALF * g.lda * 2, hstepB = (size_t)HALF * g.ldb * 2;
    const size_t tstepA = 2 * hstepA, tstepB = 2 * hstepB;
    const unsigned ldsw = (unsigned)wid * 1024u;
    const int aoff = lds_byte(wr * 64 + fr, fq * 8), boff = lds_byte(wc * 32 + fr, fq * 8);
#define PG8_SA(b, h) (((b) * 2 + (h)) * HTB)
#define PG8_SB(b, h) ((4 + (b) * 2 + (h)) * HTB)
#define PG8_STAGE(bufoff, gbase, voff) do { _Pragma("unroll") for (int _i = 0; _i < 2; ++_i) \
        __builtin_amdgcn_global_load_lds((const unsigned*)((const char*)(gbase) + (voff)[_i]), (PG8_LAS unsigned*)(lds + (bufoff) + ldsw + _i * 8192), 16, 0, 0); } while (0)
#define PG8_LDA(dst, b, h) do { _Pragma("unroll") for (int m = 0; m < 4; ++m) _Pragma("unroll") for (int k = 0; k < 2; ++k) dst[m][k] = *(const PG8_LAS bf16x8*)(lds + PG8_SA(b, h) + aoff + m * 2048 + k * 1024); } while (0)
#define PG8_LDB(dst, b, h) do { _Pragma("unroll") for (int n = 0; n < 2; ++n) _Pragma("unroll") for (int k = 0; k < 2; ++k) dst[n][k] = *(const PG8_LAS bf16x8*)(lds + PG8_SB(b, h) + boff + n * 2048 + k * 1024); } while (0)
#define PG8_MMA(ai, bj, At, Bt) do { __builtin_amdgcn_s_setprio(1); _Pragma("unroll") for (int m = 0; m < 4; ++m) _Pragma("unroll") for (int n = 0; n < 2; ++n) _Pragma("unroll") for (int k = 0; k < 2; ++k) \
        acc[ai][bj][m][n] = __builtin_amdgcn_mfma_f32_16x16x32_bf16(Bt[n][k], At[m][k], acc[ai][bj][m][n], 0, 0, 0); __builtin_amdgcn_s_setprio(0); } while (0)
#define PG8_WAIT_V(n) asm volatile("s_waitcnt vmcnt(" #n ")" ::: "memory")
#define PG8_WAIT_L(n) asm volatile("s_waitcnt lgkmcnt(" #n ")" ::: "memory")
#define PG8_BAR __builtin_amdgcn_s_barrier()
#define PG8_SCHED __builtin_amdgcn_sched_barrier(0)
    Unit cur, nxt; int ui = 0;
    if (!S.next(0, cur)) return;
    f32x4 acc[2][2][4][2];
#pragma unroll
    for (int a = 0; a < 2; ++a)
#pragma unroll
        for (int b = 0; b < 2; ++b)
#pragma unroll
            for (int m = 0; m < 4; ++m)
#pragma unroll
                for (int n = 0; n < 2; ++n) acc[a][b][m][n] = (f32x4){0.f, 0.f, 0.f, 0.f};
    bf16x8 At[4][2], B0[2][2], B1[2][2];
    const char* cA = (const char*)g.A + (size_t)cur.pm * tstepA; const char* cB = (const char*)g.Bt + (size_t)cur.pn * tstepB;
    S.a_ready(cur);
    if constexpr (SP2) {
        PG8_STAGE(PG8_SB(0, 0), cB, voffB); PG8_STAGE(PG8_SB(0, 1), cB + hstepB, voffB); PG8_STAGE(PG8_SA(0, 0), cA, voffA); PG8_STAGE(PG8_SA(0, 1), cA + hstepA, voffA);
        if (wr == 1) PG8_BAR;
        PG8_WAIT_V(2); PG8_BAR;
        PG8_STAGE(PG8_SB(1, 0), cB + kstep, voffB); PG8_STAGE(PG8_SA(1, 0), cA + kstep, voffA); PG8_STAGE(PG8_SB(1, 1), cB + hstepB + kstep, voffB);
        PG8_WAIT_V(6); PG8_BAR;
    } else {
        PG8_STAGE(PG8_SB(0, 0), cB, voffB); PG8_STAGE(PG8_SA(0, 0), cA, voffA); PG8_STAGE(PG8_SB(0, 1), cB + hstepB, voffB); PG8_STAGE(PG8_SA(0, 1), cA + hstepA, voffA);
        if (wr == 1) PG8_BAR;
        PG8_WAIT_V(4); PG8_BAR;
        PG8_STAGE(PG8_SB(1, 0), cB + kstep, voffB); PG8_STAGE(PG8_SA(1, 0), cA + kstep, voffA); PG8_STAGE(PG8_SB(1, 1), cB + hstepB + kstep, voffB);
        PG8_WAIT_V(6); PG8_BAR;
    }
    for (;;) {
        const bool has_next = S.next(ui + 1, nxt);
        const char* nA = has_next ? (const char*)g.A + (size_t)nxt.pm * tstepA : cA; const char* nB = has_next ? (const char*)g.Bt + (size_t)nxt.pn * tstepB : cB;
        for (int t = 0; t < nt; t += 2) {
            const bool last = (t == nt - 2);
            const char* a1 = cA + (size_t)(t + 1) * kstep;
            const char* a2 = last ? nA : cA + (size_t)(t + 2) * kstep; const char* b2 = last ? nB : cB + (size_t)(t + 2) * kstep;
            const char* a3 = a2 + kstep; const char* b3 = b2 + kstep;
            if (last && has_next) S.a_ready(nxt);
            if constexpr (SP2) {
            PG8_LDB(B0, 0, 0); PG8_LDB(B1, 0, 1); PG8_SCHED; PG8_LDA(At, 0, 0); PG8_STAGE(PG8_SA(1, 1), a1 + hstepA, voffA);
            PG8_WAIT_V(8); PG8_WAIT_L(0); PG8_BAR; PG8_MMA(0, 0, At, B0); PG8_MMA(0, 1, At, B1); PG8_BAR; PG8_SCHED;
            PG8_LDA(At, 0, 1); PG8_STAGE(PG8_SB(0, 0), b2, voffB); PG8_STAGE(PG8_SB(0, 1), b2 + hstepB, voffB); PG8_STAGE(PG8_SA(0, 0), a2, voffA);
            PG8_WAIT_V(8); PG8_WAIT_L(0); PG8_BAR; PG8_MMA(1, 0, At, B0); PG8_MMA(1, 1, At, B1); PG8_BAR; PG8_SCHED;
            PG8_LDB(B0, 1, 0); PG8_LDB(B1, 1, 1); PG8_SCHED; PG8_LDA(At, 1, 0); PG8_STAGE(PG8_SA(0, 1), a2 + hstepA, voffA);
            PG8_WAIT_V(8); PG8_WAIT_L(0); PG8_BAR; PG8_MMA(0, 0, At, B0); PG8_MMA(0, 1, At, B1); PG8_BAR; PG8_SCHED;
            PG8_LDA(At, 1, 1); PG8_STAGE(PG8_SB(1, 0), b3, voffB); PG8_STAGE(PG8_SB(1, 1), b3 + hstepB, voffB); PG8_STAGE(PG8_SA(1, 0), a3, voffA);
            PG8_WAIT_V(8); PG8_WAIT_L(0); PG8_BAR; PG8_MMA(1, 0, At, B0); PG8_MMA(1, 1, At, B1); PG8_BAR; PG8_SCHED;
            } else {
            PG8_LDB(B0, 0, 0); PG8_SCHED; PG8_LDA(At, 0, 0); PG8_STAGE(PG8_SA(1, 1), a1 + hstepA, voffA);
            PG8_WAIT_L(8); PG8_BAR; PG8_WAIT_L(0); PG8_MMA(0, 0, At, B0); PG8_BAR; PG8_SCHED;
            PG8_LDB(B1, 0, 1); PG8_STAGE(PG8_SB(0, 0), b2, voffB);
            PG8_BAR; PG8_WAIT_L(0); PG8_MMA(0, 1, At, B1); PG8_BAR;
            PG8_LDA(At, 0, 1); PG8_STAGE(PG8_SA(0, 0), a2, voffA);
            PG8_BAR; PG8_WAIT_L(0); PG8_MMA(1, 0, At, B0); PG8_BAR; PG8_SCHED;
            PG8_STAGE(PG8_SB(0, 1), b2 + hstepB, voffB);
            PG8_WAIT_V(6); PG8_BAR; PG8_MMA(1, 1, At, B1); PG8_BAR;
            PG8_LDB(B0, 1, 0); PG8_SCHED; PG8_LDA(At, 1, 0); PG8_STAGE(PG8_SA(0, 1), a2 + hstepA, voffA);
            PG8_WAIT_L(8); PG8_BAR; PG8_WAIT_L(0); PG8_MMA(0, 0, At, B0); PG8_BAR; PG8_SCHED;
            PG8_LDB(B1, 1, 1); PG8_STAGE(PG8_SB(1, 0), b3, voffB);
            PG8_BAR; PG8_WAIT_L(0); PG8_MMA(0, 1, At, B1); PG8_BAR;
            PG8_LDA(At, 1, 1); PG8_STAGE(PG8_SA(1, 0), a3, voffA);
            PG8_BAR; PG8_WAIT_L(0); PG8_MMA(1, 0, At, B0); PG8_BAR; PG8_SCHED;
            PG8_STAGE(PG8_SB(1, 1), b3 + hstepB, voffB);
            PG8_WAIT_V(6); PG8_BAR; PG8_MMA(1, 1, At, B1); PG8_BAR;
            }
        }
        if constexpr (ALIGN_EPI) { if (wr == 0) PG8_BAR; }
        if constexpr (!Epi::AFTER_DRAIN) { E(acc, cur, wr, wc, fr, fq); S.done(cur); }
        if (!has_next) break;
#pragma unroll
        for (int a = 0; a < 2; ++a)
#pragma unroll
            for (int b = 0; b < 2; ++b)
#pragma unroll
                for (int m = 0; m < 4; ++m)
#pragma unroll
                    for (int n = 0; n < 2; ++n) acc[a][b][m][n] = (f32x4){0.f, 0.f, 0.f, 0.f};
        cur = nxt; cA = nA; cB = nB; ++ui;
        if constexpr (ALIGN_EPI) { if (wr == 1) PG8_BAR; }
    }
    PG8_WAIT_V(0);
    if constexpr (!ALIGN_EPI) { if (wr == 0) PG8_BAR; }
    PG8_BAR;
    if constexpr (Epi::AFTER_DRAIN) { E.fused(acc, cur, wr, wc, fr, fq, lds, wid, lane); S.done(cur); }
#undef PG8_SA
#undef PG8_SB
#undef PG8_STAGE
#undef PG8_LDA
#undef PG8_LDB
#undef PG8_MMA
#undef PG8_WAIT_V
#undef PG8_WAIT_L
#undef PG8_BAR
#undef PG8_SCHED
}
}

#define LAS __attribute__((address_space(3)))
typedef unsigned short bf16_t;
typedef short bf16x8 __attribute__((ext_vector_type(8)));
typedef short s16x4 __attribute__((ext_vector_type(4)));
typedef float f32x4 __attribute__((ext_vector_type(4)));
typedef float f32x16 __attribute__((ext_vector_type(16)));
typedef unsigned u32x4 __attribute__((ext_vector_type(4)));
typedef unsigned u32x2 __attribute__((ext_vector_type(2)));

constexpr int DM = 1024, DFF = 2816, MG = 16384;
constexpr int EVN = 1792, EVN_REAL = 1568, ODN = 2304, ODN_PAD = 2432;
constexpr float EPS = 1e-6f, LOG2E = 1.4426950408889634f;
constexpr float LAM_INIT = 0.35550906f;
constexpr size_t MiB = 1u << 20;
constexpr size_t WS_CTL = 0, WS_T32C = 1 * MiB, WS_T32S = 2 * MiB, WS_T16C = 3 * MiB, WS_T16S = 3 * MiB + 512 * 1024;
constexpr size_t WS_FFN_IN = 4 * MiB, FFN_IN_BYTES = 11 * MiB, WS_FFN_OUT = WS_FFN_IN + 4 * FFN_IN_BYTES, FFN_OUT_BYTES = 5 * MiB + 512 * 1024;
constexpr size_t WS_EV_IN = 70 * MiB, WS_UQ = WS_EV_IN + (size_t)EVN * 1024 * 2, WS_UK = WS_UQ + 768 * 512 * 2, WS_UV = WS_UK + 512 * 256 * 2, WS_EV_OUT = WS_UV + 512 * 256 * 2;
constexpr size_t WS_OD_IN = WS_EV_OUT + 2 * MiB, WS_OD_OUT = WS_OD_IN + (size_t)ODN_PAD * 1024 * 2, WS_W_END = WS_OD_OUT + 2 * MiB;
static_assert(WS_W_END <= 84 * MiB, "weights");
constexpr size_t WS_XN = 84 * MiB;
constexpr size_t WS_R = 116 * MiB;
constexpr size_t WS_H = WS_R;
constexpr size_t WS_Z = WS_R;
constexpr size_t WS_VTA = WS_R + 56 * MiB, WS_QB = WS_R + 64 * MiB, WS_KNOPE = WS_R + 88 * MiB, WS_KB = WS_R + 104 * MiB, WS_VTB = WS_R + 128 * MiB;
constexpr size_t WS_VTC = WS_R + 72 * MiB, WS_VTD = WS_R + 88 * MiB, WS_O1 = WS_R + 96 * MiB;
constexpr size_t WS_END = WS_R + 160 * MiB;
constexpr int LDS_BYTES = 147456, MISC_OFF = 131072;

__device__ __forceinline__ float bf2f(bf16_t h) { return __uint_as_float((unsigned)h << 16); }
__device__ __forceinline__ unsigned f2bf(float f) { unsigned u = __float_as_uint(f); return (u + 0x7fffu + ((u >> 16) & 1u)) >> 16; }
__device__ __forceinline__ unsigned pk2(float lo, float hi) { return f2bf(lo) | (f2bf(hi) << 16); }
__device__ __forceinline__ float wave_sum(float v) {
#pragma unroll
    for (int o = 1; o < 64; o <<= 1) v += __shfl_xor(v, o);
    return v;
}
__device__ __forceinline__ float swap32_max(float v) { auto rr = __builtin_amdgcn_permlane32_swap(__float_as_uint(v), __float_as_uint(v), false, false); return fmaxf(__uint_as_float(rr[0]), __uint_as_float(rr[1])); }
__device__ __forceinline__ float swap32_sum(float v) { auto rr = __builtin_amdgcn_permlane32_swap(__float_as_uint(v), __float_as_uint(v), false, false); return __uint_as_float(rr[0]) + __uint_as_float(rr[1]); }
__device__ __forceinline__ unsigned cvtpk(float lo, float hi) { typedef float f2 __attribute__((ext_vector_type(2))); typedef __bf16 b2 __attribute__((ext_vector_type(2))); f2 v = {lo, hi}; b2 b = __builtin_convertvector(v, b2); return __builtin_bit_cast(unsigned, b); }

#define XB_TMO      128
#define XB_XCNT(j)  (256  + 64 * (j))
#define XB_XSUB(j)  (1280 + 64 * (j))
#define XB_XGEN(j)  (2304 + 64 * (j))
#define XB_TOP      3328
#define XB_TOPGEN   3392
#define XCD_BAR_WORDS 3456
#define XB_SPIN_CAP (1u << 18)

__device__ __forceinline__ unsigned xb_ld(unsigned* p)              { return __hip_atomic_load(p, __ATOMIC_RELAXED, __HIP_MEMORY_SCOPE_AGENT); }
__device__ __forceinline__ unsigned xb_add(unsigned* p, unsigned v) { return __hip_atomic_fetch_add(p, v, __ATOMIC_RELAXED, __HIP_MEMORY_SCOPE_AGENT); }
__device__ __forceinline__ unsigned xb_xcc_id() { return (unsigned)__builtin_amdgcn_s_getreg((3 << 11) | 20) & 0xFu; }
#define XB_SPIN(cond, bar) do { unsigned _sp = 0; while (cond) { __builtin_amdgcn_s_sleep(1); \
    if ((++_sp & 255u) == 0u) { if (xb_ld(&(bar)[XB_TMO])) break; if (_sp > XB_SPIN_CAP) { atomicAdd(&(bar)[XB_TMO], 1u); break; } } } } while (0)

struct XcdBarrier {
    unsigned* bar; unsigned x;
    volatile LAS unsigned* st;
};

__device__ __forceinline__ XcdBarrier xcd_barrier_post(unsigned* bar, volatile LAS unsigned* st) {
    XcdBarrier b; b.bar = bar; b.x = xb_xcc_id(); b.st = st;
    if (threadIdx.x == 0) (void)xb_add(&bar[XB_XCNT(b.x)], 1u);
    return b;
}
__device__ __forceinline__ void xcd_barrier_complete(unsigned* bar, unsigned x, unsigned& nloc, unsigned& nx) {
    const unsigned G = gridDim.x * gridDim.y * gridDim.z;
    unsigned sum, cnt, mine, sp = 0u;
    for (;;) {
        sum = 0u; cnt = 0u; mine = 0u;
#pragma unroll
        for (unsigned j = 0; j < 16; ++j) { const unsigned c = xb_ld(&bar[XB_XCNT(j)]); sum += c; cnt += (c > 0u) ? 1u : 0u; mine = (j == x) ? c : mine; }
        if (sum == G) break;
        __builtin_amdgcn_s_sleep(1);
        if ((++sp & 255u) == 0u) { if (xb_ld(&bar[XB_TMO])) break; if (sp > XB_SPIN_CAP) { atomicAdd(&bar[XB_TMO], 1u); break; } }
    }
    nloc = mine > 0u ? mine : 1u; nx = cnt > 0u ? cnt : 1u;
}

__device__ __forceinline__ void xcd_barrier(const XcdBarrier& b) {
    asm volatile("s_waitcnt vmcnt(0)" ::: "memory");
    __syncthreads();
    if (threadIdx.x == 0) {
        unsigned* bar = b.bar;
        __builtin_amdgcn_s_waitcnt(0);
        unsigned nloc = b.st[0], nx = b.st[1];
        if (nloc == 0u) { xcd_barrier_complete(bar, b.x, nloc, nx); b.st[0] = nloc; b.st[1] = nx; }
        const unsigned old = xb_add(&bar[XB_XSUB(b.x)], 1u);
        const unsigned gen = old / nloc;
        if (old + 1u == (gen + 1u) * nloc) {
            __builtin_amdgcn_fence(__ATOMIC_RELEASE, "agent");
            asm volatile("s_waitcnt vmcnt(0)" ::: "memory");
            const unsigned og = xb_add(&bar[XB_TOP], 1u);
            const unsigned tg = og / nx;
            if (og + 1u == (tg + 1u) * nx) xb_add(&bar[XB_TOPGEN], 1u);
            else XB_SPIN(xb_ld(&bar[XB_TOPGEN]) == tg, bar);
            __builtin_amdgcn_fence(__ATOMIC_ACQUIRE, "agent");
            xb_add(&bar[XB_XGEN(b.x)], 1u);
            asm volatile("s_waitcnt vmcnt(0)" ::: "memory");
        } else {
            XB_SPIN(xb_ld(&bar[XB_XGEN(b.x)]) == gen, bar);
            __builtin_amdgcn_fence(__ATOMIC_ACQUIRE, "agent");
            asm volatile("s_waitcnt vmcnt(0)" ::: "memory");
        }
    }
    __syncthreads();
}

__device__ __forceinline__ float max3f(float a, float b, float c) { float r; asm("v_max3_f32 %0, %1, %2, %3" : "=v"(r) : "v"(a), "v"(b), "v"(c)); return r; }
typedef float f32x2 __attribute__((ext_vector_type(2)));
template <int DQK, int DV, bool WIN, int NQ, bool DEEP = false, bool FIXM = false>
__device__ __forceinline__ void attn_core(LAS unsigned char* lds, const bf16_t* qrowp, int ldq, const bf16_t* Kp, int ldk, const bf16_t* Vtp, int ldv, int kbeg, int kend, int qtok,
                                          f32x16 (&o)[NQ][DV / 32], float (&m_out)[NQ], float (&l_out)[NQ], float sbound = 0.f) {
    constexpr int KROW = DQK * 2 + 16, KT = 64 * KROW, VROW = 144, VT = DV * VROW, BUF = KT + VT;
    constexpr int KCH = DQK / 8, NKC = 64 * KCH, NKL = (NKC + 511) / 512, NVL = DV / 64;
    constexpr float THR = 8.0f;
    int tid_ = threadIdx.x; asm volatile("" : "+v"(tid_));
    const int tid = tid_, lane = tid & 63, r32 = lane & 31, hi = lane >> 5;
    const int wq0 = __builtin_amdgcn_readfirstlane(qtok - r32);
    bf16x8 qf[NQ][DQK / 16];
#pragma unroll
    for (int g = 0; g < NQ; ++g)
#pragma unroll
        for (int s = 0; s < DQK / 16; ++s) qf[g][s] = *(const bf16x8*)(qrowp + (size_t)(32 * g) * ldq + 16 * s + 8 * hi);
    float m[NQ], l[NQ];
#pragma unroll
    for (int g = 0; g < NQ; ++g) { m[g] = FIXM ? sbound : -1e30f; l[g] = 0.f;
#pragma unroll
        for (int db = 0; db < DV / 32; ++db)
#pragma unroll
            for (int r = 0; r < 16; ++r) o[g][db][r] = 0.f; }
    u32x4 kst[2][NKL], vst[2][NVL];
    const int nt = (kend - kbeg) >> 6;
#define AT_GLOAD(set, t) do { const int key0_ = kbeg + 64 * (t); \
        _Pragma("unroll") for (int i_ = 0; i_ < NKL; ++i_) { const int c_ = tid + 512 * i_; if ((NKC % 512 == 0) || c_ < NKC) { const int row_ = c_ / KCH, cc_ = c_ % KCH; kst[set][i_] = *(const u32x4*)(Kp + (size_t)(key0_ + row_) * ldk + cc_ * 8); } } \
        _Pragma("unroll") for (int i_ = 0; i_ < NVL; ++i_) { const int c_ = tid + 512 * i_; const int d_ = c_ >> 3, cc_ = c_ & 7; vst[set][i_] = *(const u32x4*)(Vtp + (size_t)d_ * ldv + key0_ + cc_ * 8); } } while (0)
#define AT_LSTORE(set, buf) do { LAS unsigned char* B_ = lds + (buf) * BUF; \
        _Pragma("unroll") for (int i_ = 0; i_ < NKL; ++i_) { const int c_ = tid + 512 * i_; if ((NKC % 512 == 0) || c_ < NKC) { const int row_ = c_ / KCH, cc_ = c_ % KCH; *(LAS u32x4*)(B_ + row_ * KROW + cc_ * 16) = kst[set][i_]; } } \
        _Pragma("unroll") for (int i_ = 0; i_ < NVL; ++i_) { const int c_ = tid + 512 * i_; const int d_ = c_ >> 3, cc_ = c_ & 7; LAS unsigned char* p_ = B_ + KT + d_ * VROW + (cc_ >> 1) * 32 + (cc_ & 1) * 8; \
            *(LAS u32x2*)p_ = (u32x2){vst[set][i_].x, vst[set][i_].y}; *(LAS u32x2*)(p_ + 16) = (u32x2){vst[set][i_].z, vst[set][i_].w}; } } while (0)
    constexpr int NLD = NKL + NVL;
#define AT_GLOAD_ASM(set, t) do { const int key0_ = kbeg + 64 * (t); \
        _Pragma("unroll") for (int i_ = 0; i_ < NKL; ++i_) { int c_ = tid + 512 * i_; if (c_ > NKC - 1) c_ = NKC - 1; const int row_ = c_ / KCH, cc_ = c_ % KCH; const bf16_t* gp_ = Kp + (size_t)(key0_ + row_) * ldk + cc_ * 8; \
            asm volatile("global_load_dwordx4 %0, %1, off" : "=&v"(kst[set][i_]) : "v"(gp_)); } \
        _Pragma("unroll") for (int i_ = 0; i_ < NVL; ++i_) { const int c_ = tid + 512 * i_; const int d_ = c_ >> 3, cc_ = c_ & 7; const bf16_t* gp_ = Vtp + (size_t)d_ * ldv + key0_ + cc_ * 8; \
            asm volatile("global_load_dwordx4 %0, %1, off" : "=&v"(vst[set][i_]) : "v"(gp_)); } } while (0)
#define AT_WAITV(n) asm volatile("s_waitcnt vmcnt(%0)" :: "n"(n) : "memory")
    if (DEEP) { AT_GLOAD_ASM(0, 0); AT_GLOAD_ASM(1, 1); } else AT_GLOAD(0, 0);
#pragma unroll
    for (int g = 0; g < NQ; ++g)
#pragma unroll
        for (int s = 0; s < DQK / 16; ++s) asm volatile("" : "+v"(qf[g][s]));
    if (DEEP) AT_WAITV(NLD);
    AT_LSTORE(0, 0);
    __syncthreads();
    for (int t0 = 0; t0 < nt; t0 += (DEEP ? 2 : 1)) {
#pragma unroll
      for (int hf = 0; hf < (DEEP ? 2 : 1); ++hf) {
        const int t = t0 + hf;
        if (DEEP) { if (t + 2 < nt) AT_GLOAD_ASM(hf, t + 2); } else { if (t + 1 < nt) AT_GLOAD(0, t + 1); }
        const int key0 = kbeg + 64 * t;
        bool live = true;
        if (WIN) live = !(key0 + 63 < wq0 - 128 || key0 > wq0 + 32 * NQ - 1 + 128);
        if (live) {
            LAS unsigned char* B = lds + (t & 1) * BUF;
            f32x16 p[NQ][2];
            const float ci = 0.f;
            const f32x16 zero16 = {ci, ci, ci, ci, ci, ci, ci, ci, ci, ci, ci, ci, ci, ci, ci, ci};
            constexpr int NS = DQK / 16, NDB = DV / 32, NVF = 4 * NDB, NFR = 8, JB = 8 / NDB;

            bf16x8 fr[NFR];
#define AT_SBAR() __builtin_amdgcn_sched_barrier(0)
#pragma unroll
            for (int s0 = 0; s0 < NS; s0 += 4) {
#pragma unroll
                for (int s2 = 0; s2 < 4; ++s2) if (s0 + s2 < NS) {
                    fr[2 * s2] = *(const LAS bf16x8*)(B + r32 * KROW + (16 * (s0 + s2) + 8 * hi) * 2);
                    fr[2 * s2 + 1] = *(const LAS bf16x8*)(B + (32 + r32) * KROW + (16 * (s0 + s2) + 8 * hi) * 2); }
                AT_SBAR();
#pragma unroll
                for (int s2 = 0; s2 < 4; ++s2) if (s0 + s2 < NS) {
#pragma unroll
                    for (int g = 0; g < NQ; ++g) {
                        p[g][0] = __builtin_amdgcn_mfma_f32_32x32x16_bf16(fr[2 * s2], qf[g][s0 + s2], (s0 + s2) == 0 ? zero16 : p[g][0], 0, 0, 0);
                        p[g][1] = __builtin_amdgcn_mfma_f32_32x32x16_bf16(fr[2 * s2 + 1], qf[g][s0 + s2], (s0 + s2) == 0 ? zero16 : p[g][1], 0, 0, 0); } }
                AT_SBAR();
            }
#define AT_VLOAD(j0) do { _Pragma("unroll") for (int j_ = 0; j_ < JB; ++j_) _Pragma("unroll") for (int db_ = 0; db_ < NDB; ++db_) { fr[j_ * NDB + db_] = *(const LAS bf16x8*)(B + KT + (32 * db_ + r32) * VROW + 32 * ((j0) + j_) + 16 * hi); } AT_SBAR(); } while (0)
            if (NQ == 1) AT_VLOAD(0);
#pragma unroll
            for (int g = 0; g < NQ; ++g) {
                if (WIN) {
                    const int kb = key0 + 4 * hi - (qtok + 32 * g);
#pragma unroll
                    for (int r = 0; r < 16; ++r) { const int d0 = kb + (r & 3) + 8 * (r >> 2), d1 = d0 + 32;
                        if (d0 > 128 || d0 < -128) p[g][0][r] = -1e30f;
                        if (d1 > 128 || d1 < -128) p[g][1][r] = -1e30f; }
                }
                if constexpr (FIXM) {
                    f32x2 sum2 = {0.f, 0.f};
#pragma unroll
                    for (int h2 = 0; h2 < 2; ++h2)
#pragma unroll
                        for (int r = 0; r < 16; r += 2) { const f32x2 d2 = (f32x2){p[g][h2][r], p[g][h2][r + 1]} - (f32x2){sbound, sbound}; f32x2 e2; e2.x = __builtin_amdgcn_exp2f(d2.x); e2.y = __builtin_amdgcn_exp2f(d2.y); p[g][h2][r] = e2.x; p[g][h2][r + 1] = e2.y; sum2 += e2; }
                    l[g] += sum2.x + sum2.y;
                } else {
                if (!WIN) asm volatile("s_nop 15\n\ts_nop 7" : "+v"(p[g][0]), "+v"(p[g][1]));
                float mxa = max3f(p[g][0][0], p[g][1][0], p[g][0][1]), mxb = max3f(p[g][1][1], p[g][0][2], p[g][1][2]);
#pragma unroll
                for (int r = 3; r < 15; r += 2) { mxa = max3f(mxa, p[g][0][r], p[g][1][r]); mxb = max3f(mxb, p[g][0][r + 1], p[g][1][r + 1]); }
                float mx = max3f(mxa, mxb, max3f(p[g][0][15], p[g][1][15], p[g][0][15]));
                mx = swap32_max(mx);
                if (__any(mx > m[g] + THR)) {
                    const float mn = fmaxf(m[g], mx), alpha = __builtin_amdgcn_exp2f(m[g] - mn);
                    m[g] = mn; l[g] *= alpha;
#pragma unroll
                    for (int db = 0; db < NDB; ++db)
#pragma unroll
                        for (int r = 0; r < 16; ++r) o[g][db][r] *= alpha;
                }
                const float mr = m[g];
                f32x2 sum2 = {0.f, 0.f}; const f32x2 mr2 = {mr, mr};
#pragma unroll
                for (int h2 = 0; h2 < 2; ++h2)
#pragma unroll
                    for (int r = 0; r < 16; r += 2) { const f32x2 d2 = (f32x2){p[g][h2][r], p[g][h2][r + 1]} - mr2; f32x2 e2; e2.x = __builtin_amdgcn_exp2f(d2.x); e2.y = __builtin_amdgcn_exp2f(d2.y);
                        p[g][h2][r] = e2.x; p[g][h2][r + 1] = e2.y; sum2 += e2; }
                l[g] += sum2.x + sum2.y;
                }
            }
            if (FIXM) AT_SBAR();
            if (NQ != 1) AT_VLOAD(0);
#pragma unroll
            for (int j = 0; j < 4; ++j) {
                if (JB < 4 && j == JB) { AT_SBAR(); AT_VLOAD(JB); }
                bf16x8 pb[NQ];
#pragma unroll
                for (int g = 0; g < NQ; ++g) { const int b2 = 8 * (j & 1); const f32x16& ps = p[g][j >> 1];
                    u32x4 pw; pw.x = cvtpk(ps[b2], ps[b2 + 1]); pw.y = cvtpk(ps[b2 + 2], ps[b2 + 3]); pw.z = cvtpk(ps[b2 + 4], ps[b2 + 5]); pw.w = cvtpk(ps[b2 + 6], ps[b2 + 7]);
                    pb[g] = __builtin_bit_cast(bf16x8, pw); }
#pragma unroll
                for (int db = 0; db < NDB; ++db)
#pragma unroll
                    for (int g = 0; g < NQ; ++g) o[g][db] = __builtin_amdgcn_mfma_f32_32x32x16_bf16(fr[(j % JB) * NDB + db], pb[g], o[g][db], 0, 0, 0);
            }
            AT_SBAR();
#undef AT_SBAR
#undef AT_VLOAD
        }
        if (DEEP) { if (t + 2 < nt) AT_WAITV(NLD); else AT_WAITV(0); if (t + 1 < nt) AT_LSTORE(1 - hf, 1 - hf); } else { if (t + 1 < nt) AT_LSTORE(0, (t + 1) & 1); }
        __syncthreads();
      }
    }
#undef AT_GLOAD
#undef AT_GLOAD_ASM
#undef AT_WAITV
#undef AT_LSTORE
#pragma unroll
    for (int g = 0; g < NQ; ++g) { m_out[g] = m[g]; l_out[g] = l[g]; }
}
template <int DV>
__device__ __forceinline__ void store_o(const f32x16 (&o)[DV / 32], float scale, bf16_t* dst, int hi) {
#pragma unroll
    for (int db = 0; db < DV / 32; ++db)
#pragma unroll
        for (int rq = 0; rq < 4; ++rq) {
            u32x2 w; w.x = cvtpk(o[db][4 * rq] * scale, o[db][4 * rq + 1] * scale); w.y = cvtpk(o[db][4 * rq + 2] * scale, o[db][4 * rq + 3] * scale);
            *(u32x2*)(dst + 32 * db + 8 * rq + 4 * hi) = w;
        }
}

__device__ __forceinline__ void rownorm_rows(const float* x, const float* g, bf16_t* xn, int gw, int NGW, int lane) {
    const f32x4* gr = (const f32x4*)g + lane;
    f32x4 gg[4], nx[4];
#pragma unroll
    for (int j = 0; j < 4; ++j) { gg[j] = gr[64 * j]; nx[j] = ((const f32x4*)(x + (size_t)gw * DM) + lane)[64 * j]; }
    for (int r = gw; r < MG; r += NGW) {
        f32x4 v[4]; float s = 0.f;
#pragma unroll
        for (int j = 0; j < 4; ++j) { v[j] = nx[j]; s += (v[j].x * v[j].x + v[j].y * v[j].y) + (v[j].z * v[j].z + v[j].w * v[j].w); }
        if (r + NGW < MG) {
#pragma unroll
            for (int j = 0; j < 4; ++j) nx[j] = ((const f32x4*)(x + (size_t)(r + NGW) * DM) + lane)[64 * j]; }
        const float rs = 1.0f / sqrtf(wave_sum(s) * (1.f / DM) + EPS);
        unsigned long long* o8 = (unsigned long long*)(xn + (size_t)r * DM) + lane;
#pragma unroll
        for (int j = 0; j < 4; ++j) o8[64 * j] = (unsigned long long)pk2(v[j].x * rs * gg[j].x, v[j].y * rs * gg[j].y) | ((unsigned long long)pk2(v[j].z * rs * gg[j].z, v[j].w * rs * gg[j].w) << 32);
    }
}
__device__ __forceinline__ float wave_max(float v) {
#pragma unroll
    for (int o = 1; o < 64; o <<= 1) v = fmaxf(v, __shfl_xor(v, o));
    return __uint_as_float(__builtin_amdgcn_readfirstlane(__float_as_uint(v)));
}
template <int N> __device__ __forceinline__ void wave_sum_n(float (&v)[N]) {
#pragma unroll
    for (int o = 1; o < 64; o <<= 1)
#pragma unroll
        for (int i = 0; i < N; ++i) v[i] += __shfl_xor(v[i], o);
}
template <int MODE>
__device__ __forceinline__ void head64_norm_rope(bf16_t* p, const float* g, const float* tc, const float* ts, int pos, float oscale, int lane) {
    const float v = bf2f(p[lane]);
    const float rs = 1.0f / sqrtf(wave_sum(v * v) * (1.f / 64.f) + EPS);
    const float y = v * rs * g[lane];
    float out;
    if (MODE == 0) { const float pr = __shfl_xor(y, 32); const int i = lane & 31; const float c = tc[pos * 32 + i], s = ts[pos * 32 + i]; out = (lane < 32) ? (y * c - pr * s) : (pr * s + y * c); }
    else { const float pr = __shfl_xor(y, 16); const int i = lane & 15; const int pp = (lane < 32) ? (pos >> 6) : (pos & 63); const float c = tc[pp * 16 + i], s = ts[pp * 16 + i]; out = ((lane & 16) == 0) ? (y * c - pr * s) : (pr * s + y * c); }
    p[lane] = (bf16_t)f2bf(out * oscale);
}
__device__ __forceinline__ void head96_norm_rope(const bf16_t* src1, const bf16_t* src2, bf16_t* dst, const float* g, const float* tc, const float* ts, int pos, float oscale, int lane) {
    const float v1 = bf2f(src1[lane]); const float v2 = (lane < 32) ? bf2f(src2[lane]) : 0.f;
    const float rs = 1.0f / sqrtf(wave_sum(v1 * v1 + v2 * v2) * (1.f / 96.f) + EPS);
    const float y1 = v1 * rs * g[lane], y2 = v2 * rs * g[64 + (lane & 31)];
    const float pr = __shfl_xor(y2, 16); const int i = lane & 15; const float c = tc[pos * 16 + i], s = ts[pos * 16 + i];
    const float o2 = ((lane & 16) == 0) ? (y2 * c - pr * s) : (pr * s + y2 * c);
    dst[lane] = (bf16_t)f2bf(y1 * oscale);
    if (lane < 32) dst[64 + lane] = (bf16_t)f2bf(o2 * oscale);
}

__device__ __forceinline__ void titem_load(const float* W, int N, int k0, int n0, int lane, float (&wv)[32]) {
#pragma unroll
    for (int i = 0; i < 32; ++i) { const int kk = 2 * i + (lane >> 5); wv[i] = W[(size_t)(k0 + kk) * N + n0 + (lane & 31)]; }
}
__device__ __forceinline__ void titem_store(const float (&wv)[32], int K, bf16_t* WT, int drow, LAS float* scr, int k0, int lane) {
#pragma unroll
    for (int i = 0; i < 32; ++i) { const int kk = 2 * i + (lane >> 5); scr[kk * 33 + (lane & 31)] = wv[i]; }
    asm volatile("s_waitcnt lgkmcnt(0)" ::: "memory");
    const int c = lane & 7;
#pragma unroll
    for (int j = 0; j < 4; ++j) { const int n = (lane >> 3) + 8 * j; const LAS float* s = scr + (8 * c) * 33 + n;
        u32x4 o; o.x = pk2(s[0 * 33], s[1 * 33]); o.y = pk2(s[2 * 33], s[3 * 33]); o.z = pk2(s[4 * 33], s[5 * 33]); o.w = pk2(s[6 * 33], s[7 * 33]);
        *(u32x4*)(WT + (size_t)(drow + n) * K + k0 + 8 * c) = o; }
    asm volatile("s_waitcnt lgkmcnt(0)" ::: "memory");
}
__device__ __forceinline__ void convert_matrix(const float* W, int K, int N, bf16_t* WT, bf16_t* WT2, int mode, LAS float* scr, int gw, int NGW, int lane) {
    const int nblk = N / 32, nitems = (K / 64) * nblk;
    float wn[32];
    if (gw < nitems) titem_load(W, N, 64 * (gw / nblk), 32 * (gw % nblk), lane, wn);
    for (int it = gw; it < nitems; it += NGW) {
        const int kb = it / nblk, nb = it % nblk, n0 = 32 * nb; int drow = n0; bf16_t* dst = WT;
        if (mode == 1) { if (n0 < DFF) drow = 256 * (n0 / 128) + (n0 % 128); else { const int u = n0 - DFF; drow = 256 * (u / 128) + 128 + (u % 128); } }
        else if (mode == 2) { const int h = n0 / 128, w = n0 % 128; if (w < 64) drow = h * 64 + w; else { dst = WT2; drow = h * 64 + w - 64; } }
        float wc[32];
#pragma unroll
        for (int i = 0; i < 32; ++i) wc[i] = wn[i];
        const int it2 = it + NGW;
        if (it2 < nitems) titem_load(W, N, 64 * (it2 / nblk), 32 * (it2 % nblk), lane, wn);
        titem_store(wc, K, dst, drow, scr, 64 * kb, lane);
    }
}

__constant__ float INV32[32] = {1.0f, 0.7498942613601685f, 0.5623413324356079f, 0.4216965138912201f, 0.3162277638912201f, 0.23713737726211548f, 0.17782793939113617f, 0.133352130651474f, 0.10000000149011612f, 0.07498941570520401f, 0.05623413249850273f, 0.04216965287923813f, 0.03162277489900589f, 0.023713737726211548f, 0.017782794311642647f, 0.01333521492779255f, 0.009999999776482582f, 0.007498941849917173f, 0.005623413249850273f, 0.0042169648222625256f, 0.003162277629598975f, 0.00237137358635664f, 0.0017782794311642647f, 0.0013335214462131262f, 0.0010000000474974513f, 0.0007498942431993783f, 0.000562341301701963f, 0.0004216965171508491f, 0.0003162277571391314f, 0.00023713737027719617f, 0.00017782794020604342f, 0.0001333521504420787f};
__constant__ float INV16[16] = {1.0f, 0.5623413324356079f, 0.3162277638912201f, 0.17782793939113617f, 0.10000000149011612f, 0.05623413249850273f, 0.03162277489900589f, 0.017782794311642647f, 0.009999999776482582f, 0.005623413249850273f, 0.003162277629598975f, 0.0017782794311642647f, 0.0010000000474974513f, 0.000562341301701963f, 0.0003162277571391314f, 0.00017782794020604342f};
struct Args { const float* in[29]; float* out; unsigned char* ws; };

__global__ void __launch_bounds__(512) hybrid_fwd(Args a) {
    extern __shared__ __attribute__((aligned(16))) unsigned char lds_raw[];
    LAS unsigned char* lds = (LAS unsigned char*)lds_raw;
    cg::grid_group grid = cg::this_grid();
    const int tid = threadIdx.x, lane = tid & 63, wid = __builtin_amdgcn_readfirstlane(tid >> 6);
    const int G = gridDim.x, gw = blockIdx.x * 8 + wid, NGW = G * 8;
#define ctl ((unsigned*)(a.ws + WS_CTL))
#define T32C ((float*)(a.ws + WS_T32C))
#define T32S ((float*)(a.ws + WS_T32S))
#define T16C ((float*)(a.ws + WS_T16C))
#define T16S ((float*)(a.ws + WS_T16S))
#define XN ((bf16_t*)(a.ws + WS_XN))
#define HB ((bf16_t*)(a.ws + WS_H))
#define Z ((bf16_t*)(a.ws + WS_Z))
#define W_EV_IN ((bf16_t*)(a.ws + WS_EV_IN))
#define W_UQ ((bf16_t*)(a.ws + WS_UQ))
#define W_UK ((bf16_t*)(a.ws + WS_UK))
#define W_UV ((bf16_t*)(a.ws + WS_UV))
#define W_EV_OUT ((bf16_t*)(a.ws + WS_EV_OUT))
#define W_OD_IN ((bf16_t*)(a.ws + WS_OD_IN))
#define W_OD_OUT ((bf16_t*)(a.ws + WS_OD_OUT))
#define VTA ((bf16_t*)(a.ws + WS_VTA))
#define QB ((bf16_t*)(a.ws + WS_QB))
#define KNOPE ((bf16_t*)(a.ws + WS_KNOPE))
#define KB ((bf16_t*)(a.ws + WS_KB))
#define VTB ((bf16_t*)(a.ws + WS_VTB))
#define VTC ((bf16_t*)(a.ws + WS_VTC))
#define VTD ((bf16_t*)(a.ws + WS_VTD))
#define O1 ((float*)(a.ws + WS_O1))
#define XBUF ((unsigned*)(a.ws + WS_CTL + 512 * 1024))
    volatile LAS unsigned* misc = (volatile LAS unsigned*)(lds + MISC_OFF);
    if (threadIdx.x < 16) misc[threadIdx.x] = 0u;
    __syncthreads();
    const XcdBarrier xbar = xcd_barrier_post(ctl + 1024, misc + 8);

    {
        LAS float* scr = (LAS float*)(lds + wid * 16384);
        for (int f = 0; f < 4; ++f) {
            const int l = f >> 1, which = f & 1;
            convert_matrix((which ? a.in[6] : a.in[3]) + (size_t)l * DM * 2 * DFF, DM, 2 * DFF, (bf16_t*)(a.ws + WS_FFN_IN + f * FFN_IN_BYTES), nullptr, 1, scr, gw, NGW, lane);
            convert_matrix((which ? a.in[7] : a.in[4]) + (size_t)l * DFF * DM, DFF, DM, (bf16_t*)(a.ws + WS_FFN_OUT + f * FFN_OUT_BYTES), nullptr, 0, scr, gw, NGW, lane);
        }
        convert_matrix(a.in[9], DM, EVN_REAL, W_EV_IN, nullptr, 0, scr, gw, NGW, lane);
        convert_matrix(a.in[14], 512, 768, W_UQ, nullptr, 0, scr, gw, NGW, lane);
        convert_matrix(a.in[16], 256, 1024, W_UK, W_UV, 2, scr, gw, NGW, lane);
        convert_matrix(a.in[19], DM, DM, W_EV_OUT, nullptr, 0, scr, gw, NGW, lane);
        convert_matrix(a.in[21], DM, ODN, W_OD_IN, nullptr, 0, scr, gw, NGW, lane);
        convert_matrix(a.in[28], DM, DM, W_OD_OUT, nullptr, 0, scr, gw, NGW, lane);
        { const int gt = blockIdx.x * 512 + tid, NT = G * 512; const u32x4 z4 = (u32x4){0u, 0u, 0u, 0u};
          u32x4* p1 = (u32x4*)(W_EV_IN + (size_t)EVN_REAL * 1024); for (int i = gt; i < (EVN - EVN_REAL) * 1024 / 8; i += NT) p1[i] = z4;
          u32x4* p2 = (u32x4*)(W_OD_IN + (size_t)ODN * 1024); for (int i = gt; i < (ODN_PAD - ODN) * 1024 / 8; i += NT) p2[i] = z4;
          for (int e = gt; e < 8192 * 32; e += NT) { const int p = e >> 5, i = e & 31; const float ang = (float)p * INV32[i]; const double rev = (double)ang * 0.15915494309189535; const float fr = (float)(rev - __builtin_rint(rev));
              T32C[e] = __builtin_amdgcn_cosf(fr); T32S[e] = __builtin_amdgcn_sinf(fr); }
          for (int e = gt; e < 8192 * 16; e += NT) { const int p = e >> 4, i = e & 15; const float ang = (float)p * INV16[i]; const double rev = (double)ang * 0.15915494309189535; const float fr = (float)(rev - __builtin_rint(rev));
              T16C[e] = __builtin_amdgcn_cosf(fr); T16S[e] = __builtin_amdgcn_sinf(fr); } }
    }
    rownorm_rows(a.in[0], a.in[2], XN, gw, NGW, lane);
    grid.sync();

    for (int p = 0; p < 56; ++p) {
        const int st = p % 14, l = (p / 14) & 1, g = p / 28;
        const bool even = (l == 0);
        if ((!even && (st == 6 || st == 7)) || st == 9 || st == 3 || st == 11 || (st == 0 && (l == 1 || g == 0))) continue;
        const int S = g ? 4096 : 8192, nqb = S / 256;
        int tidp = threadIdx.x; asm volatile("" : "+v"(tidp));
        const int tid = tidp, lane = tid & 63, wid = __builtin_amdgcn_readfirstlane(tid >> 6), gw = blockIdx.x * 8 + wid;
        float* xo = a.out + (size_t)g * MG * DM;
        switch (st) {
        case 0: case 3: case 11: {
            const float* xsrc = (l == 0 && st == 0) ? (g ? a.in[1] : a.in[0]) : xo;
            const float* gn = (st == 0) ? a.in[2] + l * DM : (st == 11) ? a.in[5] + l * DM : (even ? a.in[8] : a.in[20]);
            rownorm_rows(xsrc, gn, XN, gw, NGW, lane);
        } break;
        case 1: case 12: {
            const int f = (st == 12);
            pg8::Gemm gm{XN, (const bf16_t*)(a.ws + WS_FFN_IN + (size_t)(l * 2 + f) * FFN_IN_BYTES), MG, 2 * DFF, DM, DM, DM}; pg8::StaticOrder So; So.init(MG, 2 * DFF, G, (int)blockIdx.x);
            pg8::EpiSwiglu E{HB, DFF}; pg8::gemm_phase<pg8::EpiSwiglu, pg8::StaticOrder, true, true>(lds, gm, So, E);
        } break;
        case 2: case 13: {
            const int f = (st == 13);
            const float* xsrc = (l == 0 && f == 0) ? (g ? a.in[1] : a.in[0]) : xo;
            const float* gnext = (f == 0) ? (even ? a.in[8] : a.in[20]) : (a.in[2] + DM);
            pg8::Gemm gm{HB, (const bf16_t*)(a.ws + WS_FFN_OUT + (size_t)(l * 2 + f) * FFN_OUT_BYTES), MG, DM, DFF, DFF, DFF}; pg8::StaticOrder So; So.init(MG, DM, G, (int)blockIdx.x);
            pg8::EpiResidNorm E{xsrc, xo, DM, 0.5f, gnext, XN, XBUF, ctl + 8192 + ((g * 2 + l) * 3 + (f ? 2 : 0)) * 1024}; pg8::gemm_phase<pg8::EpiResidNorm, pg8::StaticOrder, false, true>(lds, gm, So, E);
        } break;
        case 4: {
            if (even) {
                { pg8::Gemm gm{XN, W_EV_IN, MG, EVN, DM, DM, DM}; pg8::StaticOrder So; So.init(MG, EVN, G, (int)blockIdx.x); pg8::EpiStore E{Z, EVN}; pg8::gemm_phase<pg8::EpiStore, pg8::StaticOrder, true, true>(lds, gm, So, E); }
                { pg8::Gemm gm{W_EV_IN + (size_t)640 * DM, XN, 256, MG, DM, DM, DM}; pg8::StaticOrder So; So.init(256, MG, G, (int)((blockIdx.x + 64) & 255)); pg8::EpiStore E{VTA, MG}; pg8::gemm_phase<pg8::EpiStore, pg8::StaticOrder, true, true>(lds, gm, So, E); }
            } else {
                { pg8::Gemm gm{XN, W_OD_IN, MG, ODN, DM, DM, DM}; pg8::StaticOrder So; So.init(MG, ODN, G, (int)blockIdx.x); pg8::EpiStore E{Z, ODN}; pg8::gemm_phase<pg8::EpiStore, pg8::StaticOrder, true, true>(lds, gm, So, E); }
                { pg8::Gemm gm{W_OD_IN + (size_t)1024 * DM, XN, 512, MG, DM, DM, DM}; pg8::StaticOrder So; So.init(512, MG, G, (int)((blockIdx.x + 192) & 255)); pg8::EpiStore E{VTC, MG}; pg8::gemm_phase<pg8::EpiStore, pg8::StaticOrder, true, true>(lds, gm, So, E); }
                { pg8::Gemm gm{W_OD_IN + (size_t)2176 * DM, XN, 256, MG, DM, DM, DM}; pg8::StaticOrder So; So.init(256, MG, G, (int)((blockIdx.x + 64) & 255)); pg8::EpiStore E{VTD, MG}; pg8::gemm_phase<pg8::EpiStore, pg8::StaticOrder, true, true>(lds, gm, So, E); }
            }
        } break;
        case 5: {
            if (even) {
                const float gq = a.in[10][lane], gk = a.in[11][lane];
                const f32x4 gc0 = *(const f32x4*)(a.in[13] + lane * 8), gc1 = *(const f32x4*)(a.in[13] + lane * 8 + 4), gv0 = *(const f32x4*)(a.in[15] + lane * 4);
                bf16_t nx[10]; u32x4 nq; u32x2 nk;
                { const bf16_t* z0 = Z + (size_t)gw * EVN;
#pragma unroll
                  for (int hh = 0; hh < 10; ++hh) nx[hh] = z0[hh * 64 + lane];
                  nq = *(const u32x4*)(z0 + 768 + lane * 8); nk = *(const u32x2*)(z0 + 1280 + lane * 4); }
                for (int r = gw; r < MG; r += NGW) { bf16_t* zr = Z + (size_t)r * EVN; const int pos = r & (S - 1);
                    float v[10], ss[12];
#pragma unroll
                    for (int hh = 0; hh < 10; ++hh) v[hh] = bf2f(nx[hh]);
                    const u32x4 rq = nq; const u32x2 rk = nk;
                    if (r + NGW < MG) { const bf16_t* z1 = zr + (size_t)NGW * EVN;
#pragma unroll
                        for (int hh = 0; hh < 10; ++hh) nx[hh] = z1[hh * 64 + lane];
                        nq = *(const u32x4*)(z1 + 768 + lane * 8); nk = *(const u32x2*)(z1 + 1280 + lane * 4); }
                    const float c = T32C[pos * 32 + (lane & 31)], sn = T32S[pos * 32 + (lane & 31)];
                    float cq[8], ck[4];
                    cq[0] = __uint_as_float(rq.x << 16); cq[1] = __uint_as_float(rq.x & 0xffff0000u); cq[2] = __uint_as_float(rq.y << 16); cq[3] = __uint_as_float(rq.y & 0xffff0000u);
                    cq[4] = __uint_as_float(rq.z << 16); cq[5] = __uint_as_float(rq.z & 0xffff0000u); cq[6] = __uint_as_float(rq.w << 16); cq[7] = __uint_as_float(rq.w & 0xffff0000u);
                    ck[0] = __uint_as_float(rk.x << 16); ck[1] = __uint_as_float(rk.x & 0xffff0000u); ck[2] = __uint_as_float(rk.y << 16); ck[3] = __uint_as_float(rk.y & 0xffff0000u);
#pragma unroll
                    for (int hh = 0; hh < 10; ++hh) ss[hh] = v[hh] * v[hh];
                    ss[10] = ((cq[0] * cq[0] + cq[1] * cq[1]) + (cq[2] * cq[2] + cq[3] * cq[3])) + ((cq[4] * cq[4] + cq[5] * cq[5]) + (cq[6] * cq[6] + cq[7] * cq[7]));
                    ss[11] = (ck[0] * ck[0] + ck[1] * ck[1]) + (ck[2] * ck[2] + ck[3] * ck[3]);
                    wave_sum_n<12>(ss);
                    float y[10], pr[10];
#pragma unroll
                    for (int hh = 0; hh < 10; ++hh) { y[hh] = v[hh] * (1.0f / sqrtf(ss[hh] * (1.f / 64.f) + EPS)) * (hh < 8 ? gq : gk); pr[hh] = __shfl_xor(y[hh], 32); }
#pragma unroll
                    for (int hh = 0; hh < 10; ++hh) { const float o = (lane < 32) ? (y[hh] * c - pr[hh] * sn) : (pr[hh] * sn + y[hh] * c); zr[hh * 64 + lane] = (bf16_t)f2bf(o * (hh < 8 ? 0.125f * LOG2E : 1.0f)); }
                    { const float rs = 1.0f / sqrtf(ss[10] * (1.f / 512.f) + EPS);
                      u32x4 w; w.x = pk2(cq[0] * rs * gc0.x, cq[1] * rs * gc0.y); w.y = pk2(cq[2] * rs * gc0.z, cq[3] * rs * gc0.w); w.z = pk2(cq[4] * rs * gc1.x, cq[5] * rs * gc1.y); w.w = pk2(cq[6] * rs * gc1.z, cq[7] * rs * gc1.w);
                      *(u32x4*)(zr + 768 + lane * 8) = w; }
                    { const float rs = 1.0f / sqrtf(ss[11] * (1.f / 256.f) + EPS);
                      u32x2 w; w.x = pk2(ck[0] * rs * gv0.x, ck[1] * rs * gv0.y); w.y = pk2(ck[2] * rs * gv0.z, ck[3] * rs * gv0.w);
                      *(u32x2*)(zr + 1280 + lane * 4) = w; } }
            } else {
                const float gcq = a.in[22][lane], gck = a.in[23][lane], gdq = a.in[26][lane], gdk = a.in[27][lane];
                bf16_t nx[26];
                { const bf16_t* z0 = Z + (size_t)gw * ODN;
#pragma unroll
                  for (int hh = 0; hh < 16; ++hh) nx[hh] = z0[hh * 64 + lane];
#pragma unroll
                  for (int hh = 0; hh < 10; ++hh) nx[16 + hh] = z0[1536 + hh * 64 + lane]; }
                for (int r = gw; r < MG; r += NGW) { bf16_t* zr = Z + (size_t)r * ODN; const int pos = r & (S - 1);
                    float v[26], ss[26];
#pragma unroll
                    for (int hh = 0; hh < 26; ++hh) v[hh] = bf2f(nx[hh]);
                    if (r + NGW < MG) { const bf16_t* z1 = zr + (size_t)NGW * ODN;
#pragma unroll
                        for (int hh = 0; hh < 16; ++hh) nx[hh] = z1[hh * 64 + lane];
#pragma unroll
                        for (int hh = 0; hh < 10; ++hh) nx[16 + hh] = z1[1536 + hh * 64 + lane]; }
                    const float c = T32C[pos * 32 + (lane & 31)], sn = T32S[pos * 32 + (lane & 31)];
                    const int pp = (lane < 32) ? (pos >> 6) : (pos & 63); const float c2 = T16C[pp * 16 + (lane & 15)], s2 = T16S[pp * 16 + (lane & 15)];
#pragma unroll
                    for (int hh = 0; hh < 26; ++hh) ss[hh] = v[hh] * v[hh];
                    wave_sum_n<26>(ss);
#pragma unroll
                    for (int hh = 0; hh < 16; ++hh) { const float y = v[hh] * (1.0f / sqrtf(ss[hh] * (1.f / 64.f) + EPS)) * (hh < 8 ? gcq : gck); const float pr = __shfl_xor(y, 32);
                        const float o = (lane < 32) ? (y * c - pr * sn) : (pr * sn + y * c); zr[hh * 64 + lane] = (bf16_t)f2bf(o * (hh < 8 ? 0.125f * LOG2E : 1.0f)); }
#pragma unroll
                    for (int hh = 0; hh < 10; ++hh) { const float y = v[16 + hh] * (1.0f / sqrtf(ss[16 + hh] * (1.f / 64.f) + EPS)) * (hh < 8 ? gdq : gdk); const float pr = __shfl_xor(y, 16);
                        const float o = ((lane & 16) == 0) ? (y * c2 - pr * s2) : (pr * s2 + y * c2); zr[1536 + hh * 64 + lane] = (bf16_t)f2bf(o * (hh < 8 ? 0.125f * LOG2E : 1.0f)); } }
            }
        } break;
        case 6: {
            { pg8::Gemm gm{Z + 768, W_UQ, MG, 768, 512, EVN, 512}; pg8::StaticOrder So; So.init(MG, 768, G, (int)blockIdx.x); pg8::EpiStore E{QB, 768}; pg8::gemm_phase<pg8::EpiStore, pg8::StaticOrder, true, true>(lds, gm, So, E); }
            { pg8::Gemm gm{Z + 1280, W_UK, MG, 512, 256, EVN, 256}; pg8::StaticOrder So; So.init(MG, 512, G, (int)((blockIdx.x + 64) & 255)); pg8::EpiStore E{KNOPE, 512}; pg8::gemm_phase<pg8::EpiStore, pg8::StaticOrder, true, true>(lds, gm, So, E); }
            { pg8::Gemm gm{W_UV, Z + 1280, 512, MG, 256, 256, EVN}; pg8::StaticOrder So; So.init(512, MG, G, (int)((blockIdx.x + 192) & 255)); pg8::EpiStore E{VTB, MG}; pg8::gemm_phase<pg8::EpiStore, pg8::StaticOrder, true, true>(lds, gm, So, E); }
        } break;
        case 7: {
            const float gq1 = a.in[17][lane], gq2 = a.in[17][64 + (lane & 31)], gk1 = a.in[18][lane], gk2 = a.in[18][64 + (lane & 31)]; const float qs = 0.10206207261596577f * LOG2E;
            bf16_t n1[8], n2[8], n3[8], nr;
            { const bf16_t* q0 = QB + (size_t)gw * 768; const bf16_t* k0 = KNOPE + (size_t)gw * 512; nr = Z[(size_t)gw * EVN + 1536 + (lane & 31)];
#pragma unroll
              for (int h = 0; h < 8; ++h) { n1[h] = q0[h * 96 + lane]; n2[h] = q0[h * 96 + 64 + (lane & 31)]; n3[h] = k0[h * 64 + lane]; } }
            for (int r = gw; r < MG; r += NGW) { const int pos = r & (S - 1);
                bf16_t* q = QB + (size_t)r * 768; bf16_t* ko = KB + (size_t)r * 768;
                float q1[8], q2[8], k1[8], ss[16];
                const float kr = (lane < 32) ? bf2f(nr) : 0.f;
#pragma unroll
                for (int h = 0; h < 8; ++h) { q1[h] = bf2f(n1[h]); q2[h] = (lane < 32) ? bf2f(n2[h]) : 0.f; k1[h] = bf2f(n3[h]); }
                if (r + NGW < MG) { const bf16_t* q0 = q + (size_t)NGW * 768; const bf16_t* k0 = KNOPE + (size_t)(r + NGW) * 512; nr = Z[(size_t)(r + NGW) * EVN + 1536 + (lane & 31)];
#pragma unroll
                    for (int h = 0; h < 8; ++h) { n1[h] = q0[h * 96 + lane]; n2[h] = q0[h * 96 + 64 + (lane & 31)]; n3[h] = k0[h * 64 + lane]; } }
                const float c = T16C[pos * 16 + (lane & 15)], sn = T16S[pos * 16 + (lane & 15)];
#pragma unroll
                for (int h = 0; h < 8; ++h) { ss[h] = q1[h] * q1[h] + q2[h] * q2[h]; ss[8 + h] = k1[h] * k1[h] + kr * kr; }
                wave_sum_n<16>(ss);
#pragma unroll
                for (int h = 0; h < 8; ++h) {
                    { const float rs = 1.0f / sqrtf(ss[h] * (1.f / 96.f) + EPS); const float y1 = q1[h] * rs * gq1, y2 = q2[h] * rs * gq2; const float pr = __shfl_xor(y2, 16);
                      const float o2 = ((lane & 16) == 0) ? (y2 * c - pr * sn) : (pr * sn + y2 * c);
                      q[h * 96 + lane] = (bf16_t)f2bf(y1 * qs); if (lane < 32) q[h * 96 + 64 + lane] = (bf16_t)f2bf(o2 * qs); }
                    { const float rs = 1.0f / sqrtf(ss[8 + h] * (1.f / 96.f) + EPS); const float y1 = k1[h] * rs * gk1, y2 = kr * rs * gk2; const float pr = __shfl_xor(y2, 16);
                      const float o2 = ((lane & 16) == 0) ? (y2 * c - pr * sn) : (pr * sn + y2 * c);
                      ko[h * 96 + lane] = (bf16_t)f2bf(y1); if (lane < 32) ko[h * 96 + 64 + lane] = (bf16_t)f2bf(o2); } } }
        } break;
        case 8: {
#ifndef ATT_REP
#define ATT_REP 1
#endif
                    for (int rep = 0; rep < ATT_REP; ++rep) {
                    unsigned* qctr = ctl + 64 * (g * 2 + l + 4 * rep);
                    float sb_mla = 0.f, sb_a = 0.f, sb_c = 0.f, sb_d = 0.f;
                    if (even) { sb_a = 1.02f * 8.0f * LOG2E * wave_max(fabsf(a.in[10][lane])) * wave_max(fabsf(a.in[11][lane]));
                                sb_mla = 1.02f * 9.797958971f * LOG2E * wave_max(fmaxf(fabsf(a.in[17][lane]), fabsf(a.in[17][64 + (lane & 31)]))) * wave_max(fmaxf(fabsf(a.in[18][lane]), fabsf(a.in[18][64 + (lane & 31)]))); }
                    else { sb_c = 1.02f * 8.0f * LOG2E * wave_max(fabsf(a.in[22][lane])) * wave_max(fabsf(a.in[23][lane]));
                           sb_d = 1.02f * 8.0f * LOG2E * wave_max(fabsf(a.in[26][lane])) * wave_max(fabsf(a.in[27][lane])); }
                    const int ntot = even ? 1024 : 768;
                    for (;;) {
                        __syncthreads();
                        if (tid == 0) misc[0] = atomicAdd(qctr, 1u);
                        __syncthreads();
                        const int u = (int)misc[0];
                        if (u >= ntot) break;
                        const int r32 = lane & 31, hi = lane >> 5;
                        const int nqb2 = S / 512;
                        if (even) {
                            if (u < 512) {
                                const int qb = u % nqb, h = (u / nqb) & 7, seq = u / (nqb * 8); const int q0 = seq * S + qb * 256, qtok = q0 + wid * 32 + r32;
                                f32x16 o[1][2]; float m[1], lp[1];
                                attn_core<96, 64, false, 1, true, true>(lds, QB + (size_t)qtok * 768 + h * 96, 768, KB + h * 96, 768, VTB + (size_t)(h * 64) * MG, MG, seq * S, seq * S + S, qtok, o, m, lp, sb_mla);
                                store_o<64>(o[0], 1.0f / swap32_sum(lp[0]), XN + (size_t)qtok * DM + 512 + h * 64, hi);
                            } else {
                                const int v = u - 512; const int qb = v % nqb, h = (v / nqb) & 7, seq = v / (nqb * 8); const int q0 = seq * S + qb * 256, qtok = q0 + wid * 32 + r32;
                                const int kbeg = (qb == 0) ? q0 : q0 - 128, kend = (qb == nqb - 1) ? q0 + 256 : q0 + 384;
                                f32x16 o[1][2]; float m[1], lp[1];
                                attn_core<64, 64, true, 1, false, false>(lds, Z + (size_t)qtok * EVN + h * 64, EVN, Z + 512 + (h >> 2) * 64, EVN, VTA + (size_t)((h >> 2) * 64) * MG, MG, kbeg, kend, qtok, o, m, lp, sb_a);
                                const float lt = swap32_sum(lp[0]) + __builtin_amdgcn_exp2f(a.in[12][h] * LOG2E - m[0]);
                                store_o<64>(o[0], 1.0f / lt, XN + (size_t)qtok * DM + h * 64, hi);
                            }
                        } else {
                            if (u >= 256) {
                                const int v = u - 256; const int qb = v % nqb, h = (v / nqb) & 7, seq = v / (nqb * 8); const int q0 = seq * S + qb * 256, qtok = q0 + wid * 32 + r32;
                                f32x16 o[1][2]; float m[1], lp[1];
                                attn_core<64, 64, false, 1, true, true>(lds, Z + (size_t)qtok * ODN + 1536 + h * 64, ODN, Z + 2048 + (h >> 2) * 64, ODN, VTD + (size_t)((h >> 2) * 64) * MG, MG, seq * S, seq * S + S, qtok, o, m, lp, sb_d);
                                store_o<64>(o[0], 1.0f / swap32_sum(lp[0]), XN + (size_t)qtok * DM + 512 + h * 64, hi);
                            } else {
                                const int qb = u % nqb, h = (u / nqb) & 3, seq = u / (nqb * 4); const int q0 = seq * S + qb * 256, qtok = q0 + wid * 32 + r32;
#pragma unroll 1
                                for (int c = 0; c < 2; ++c) {
                                    f32x16 o[1][4]; float m[1], lp[1];
                                    attn_core<64, 128, false, 1, true, true>(lds, Z + (size_t)qtok * ODN + (2 * h + c) * 64, ODN, Z + 512 + (2 * h + c) * 64, ODN, VTC + (size_t)(h * 128) * MG, MG, seq * S, seq * S + S, qtok, o, m, lp, sb_c);
                                    int tl = threadIdx.x; asm volatile("" : "+v"(tl)); float* stash = O1 + ((size_t)blockIdx.x * 8 + (tl >> 6)) * 4096 + (tl & 63);
                                    if (c == 0) { const float inv = 1.0f / swap32_sum(lp[0]);
#pragma unroll
                                        for (int db = 0; db < 4; ++db)
#pragma unroll
                                            for (int r = 0; r < 16; ++r) stash[(db * 16 + r) * 64] = o[0][db][r] * inv;
                                        asm volatile("s_waitcnt vmcnt(0)" ::: "memory");
                                    } else {
                                        const float* lpm = a.in[24];
                                        const float lam = __expf(wave_sum(lpm[tl & 63] * lpm[64 + (tl & 63)])) - __expf(wave_sum(lpm[128 + (tl & 63)] * lpm[192 + (tl & 63)])) + LAM_INIT;
                                        const float inv2 = lam / swap32_sum(lp[0]); float ss = 0.f;
#pragma unroll
                                        for (int db = 0; db < 4; ++db) {
#pragma unroll
                                            for (int r = 0; r < 16; ++r) { const float d = stash[(db * 16 + r) * 64] - o[0][db][r] * inv2; o[0][db][r] = d; ss += d * d; }
                                            asm volatile("" ::: "memory"); }
                                        const float rs = (1.0f - LAM_INIT) / sqrtf(swap32_sum(ss) * (1.f / 128.f) + EPS);
                                        const float* gon = a.in[25];
                                        bf16_t* dsto = XN + (size_t)qtok * DM + h * 128;
#pragma unroll
                                        for (int db = 0; db < 4; ++db) {
#pragma unroll
                                            for (int rq = 0; rq < 4; ++rq) { const f32x4 g4 = *(const f32x4*)(gon + 32 * db + 8 * rq + 4 * hi);
                                                u32x2 w; w.x = cvtpk(o[0][db][4 * rq] * rs * g4.x, o[0][db][4 * rq + 1] * rs * g4.y); w.y = cvtpk(o[0][db][4 * rq + 2] * rs * g4.z, o[0][db][4 * rq + 3] * rs * g4.w);
                                                *(u32x2*)(dsto + 32 * db + 8 * rq + 4 * hi) = w; }
                                            asm volatile("" ::: "memory"); }
                                    }
                                }
                            }
                        }
                    }
                    }
        } break;
        case 9: {
            const float* lpm = a.in[24]; const float* gon = a.in[25];
            const float lam = __expf(wave_sum(lpm[lane] * lpm[64 + lane])) - __expf(wave_sum(lpm[128 + lane] * lpm[192 + lane])) + LAM_INIT;
            for (int r = gw; r < MG; r += NGW) {
#pragma unroll
                for (int h = 0; h < 4; ++h) { const float* p1 = O1 + ((size_t)r * 8 + 2 * h) * 128 + 2 * lane; const float d0 = p1[0] - lam * p1[128], d1 = p1[1] - lam * p1[129];
                    const float rs = (1.0f - LAM_INIT) / sqrtf(wave_sum(d0 * d0 + d1 * d1) * (1.f / 128.f) + EPS);
                    *(unsigned*)(XN + (size_t)r * DM + h * 128 + 2 * lane) = pk2(d0 * rs * gon[2 * lane], d1 * rs * gon[2 * lane + 1]); } }
        } break;
        case 10: {
            pg8::Gemm gm{XN, even ? W_EV_OUT : W_OD_OUT, MG, DM, DM, DM, DM}; pg8::StaticOrder So; So.init(MG, DM, G, (int)blockIdx.x);
            pg8::EpiResidNorm E{xo, xo, DM, 1.0f, a.in[5] + l * DM, XN, XBUF, ctl + 8192 + ((g * 2 + l) * 3 + 1) * 1024}; pg8::gemm_phase<pg8::EpiResidNorm, pg8::StaticOrder, false, true>(lds, gm, So, E);
        } break;
        }
#ifndef SYNC_REP
#define SYNC_REP 1
#endif
        for (int rep = 0; rep < SYNC_REP; ++rep) xcd_barrier(xbar);
    }
}

extern "C" void kernel_launch(void* const* d_in, const int* in_sizes, int n_in, void* d_out, int out_size, void* d_ws, size_t ws_size, hipStream_t stream) {
    static int grid = 0;
    if (grid == 0) {
        if (n_in != 29 || ws_size < WS_END) { fprintf(stderr, "kernel_launch: unexpected inputs (n_in %d, ws %zu)\n", n_in, ws_size); grid = -1; return; }
        int dev = 0, cus = 0, per_cu = 0;
        hipGetDevice(&dev); hipDeviceGetAttribute(&cus, hipDeviceAttributeMultiprocessorCount, dev);
        hipFuncSetAttribute((const void*)hybrid_fwd, hipFuncAttributeMaxDynamicSharedMemorySize, LDS_BYTES);
        hipOccupancyMaxActiveBlocksPerMultiprocessor(&per_cu, (const void*)hybrid_fwd, 512, LDS_BYTES);
        if (per_cu < 1) per_cu = 1;
        grid = cus * (per_cu > 1 ? 1 : per_cu);
        if (grid != 256) { fprintf(stderr, "kernel_launch: this kernel needs exactly 256 workgroups (one per CU); got %d\n", grid); grid = -1; return; }
        (void)hipGetLastError();
    }
    if (grid < 0) return;
    hipMemsetAsync((char*)d_ws + WS_CTL, 0, 131072, stream);
    Args a{};
    for (int i = 0; i < 29; ++i) a.in[i] = (const float*)d_in[i];
    a.out = (float*)d_out; a.ws = (unsigned char*)d_ws;
    for (int i = 0; i < 32; ++i) INV32[i] = powf(10000.0f, -((float)(2 * i) / 64.0f));
    for (int i = 0; i < 16; ++i) INV16[i] = powf(10000.0f, -((float)(2 * i) / 32.0f));
    void* args[] = {&a};
    hipError_t e = hipLaunchCooperativeKernel((const void*)hybrid_fwd, dim3(grid), dim3(512), args, LDS_BYTES, stream);
    if (e != hipSuccess) fprintf(stderr, "cooperative launch failed: %s (grid %d)\n", hipGetErrorString(e), grid);
}
```

```cpp
#include <hip/hip_runtime.h>
#include <hip/hip_cooperative_groups.h>
#include <cstdio>
#include <cstdint>
#include <cmath>
namespace cg = cooperative_groups;
namespace pg8 {
#define PG8_LAS __attribute__((address_space(3)))
typedef unsigned short bf16_t;
typedef short bf16x8 __attribute__((ext_vector_type(8)));
typedef float f32x4 __attribute__((ext_vector_type(4)));
typedef unsigned u32x4 __attribute__((ext_vector_type(4)));
constexpr int BM = 256, BK = 64, HALF = 128, HTB = HALF * BK * 2  , STAGE_BYTES = 8 * HTB, NXCD = 8, WGM = 8;

__host__ __device__ __forceinline__ int lds_byte(int r, int c) { const int st = (r >> 4) * 2 + (c >> 5), rr = r & 15, cc = c & 31, ob = rr * 64 + cc * 2; return st * 1024 + (ob ^ (((ob >> 9) & 1) << 5)); }
__host__ __device__ __forceinline__ void stage_rc(int b, int& R, int& C) { const int st = b / 1024, sb = b % 1024, swz = sb ^ (((sb >> 9) & 1) << 5); R = (st >> 1) * 16 + swz / 64; C = (st & 1) * 32 + (swz % 64) / 2; }
__host__ __device__ __forceinline__ int perm32(int rho) { const int n = rho >> 4, i = rho & 15; return 8 * (i >> 2) + 4 * n + (i & 3); }

struct Unit { int pm, pn; };
struct Gemm { const bf16_t* A; const bf16_t* Bt; int M, N, K, lda, ldb; };

struct StaticOrder {
    int nM, nN, nwg, G, c;
    __host__ __device__ void init(int M, int N, int G_, int c_) { nM = M / BM; nN = N / BM; nwg = nM * nN; G = G_; c = c_; }
    __host__ __device__ bool next(int i, Unit& u) const {
        const long L = (long)i * G + c; if (L >= nwg) return false;
        int wgid = (int)L; { const int q = nwg / NXCD, r = nwg % NXCD, xcd = wgid % NXCD, off = wgid / NXCD; wgid = (xcd < r ? xcd * (q + 1) : r * (q + 1) + (xcd - r) * q) + off; }
        const int nig = WGM * nN, gid = wgid / nig, fm = gid * WGM, gsz = (nM - fm) < WGM ? (nM - fm) : WGM;
        u.pm = fm + ((wgid % nig) % gsz); u.pn = (wgid % nig) / gsz; return true;
    }
    __device__ __forceinline__ void a_ready(const Unit&) const {}
    __device__ __forceinline__ void done(const Unit&) const {}
};


__device__ __forceinline__ unsigned cvt_pk_bf16(float lo, float hi) { unsigned r; asm volatile("v_cvt_pk_bf16_f32 %0, %1, %2" : "=v"(r) : "v"(lo), "v"(hi)); return r; }

struct EpiStore {
    static constexpr bool PERM = true, AFTER_DRAIN = false;
    bf16_t* O; int ldc;
    __device__ __forceinline__ void operator()(const f32x4 (&acc)[2][2][4][2], const Unit& u, int wr, int wc, int fr, int fq) const {
        const int row0 = u.pm * BM + wr * 64 + fr; const int col0 = u.pn * BM + wc * 32 + 8 * fq;
#pragma unroll
        for (int ai = 0; ai < 2; ++ai)
#pragma unroll
            for (int m = 0; m < 4; ++m) { bf16_t* rowp = O + (size_t)(row0 + ai * HALF + m * 16) * ldc + col0;
#pragma unroll
                for (int bj = 0; bj < 2; ++bj) { const f32x4 v0 = acc[ai][bj][m][0], v1 = acc[ai][bj][m][1];
                    u32x4 w; w.x = cvt_pk_bf16(v0[0], v0[1]); w.y = cvt_pk_bf16(v0[2], v0[3]); w.z = cvt_pk_bf16(v1[0], v1[1]); w.w = cvt_pk_bf16(v1[2], v1[3]);
                    *(u32x4*)(rowp + bj * HALF) = w; } }
    }
};
__device__ __forceinline__ float silu_mul(float g, float u) { const float e = __builtin_amdgcn_exp2f(g * -1.4426950408889634f); return g * __builtin_amdgcn_rcpf(1.0f + e) * u; }
struct EpiSwiglu {
    static constexpr bool PERM = true, AFTER_DRAIN = false;
    bf16_t* H; int ldh;
    __device__ __forceinline__ void operator()(const f32x4 (&acc)[2][2][4][2], const Unit& u, int wr, int wc, int fr, int fq) const {
        const int row0 = u.pm * BM + wr * 64 + fr; const int col0 = u.pn * HALF + wc * 32 + 8 * fq;
#pragma unroll
        for (int ai = 0; ai < 2; ++ai)
#pragma unroll
            for (int m = 0; m < 4; ++m) { bf16_t* rowp = H + (size_t)(row0 + ai * HALF + m * 16) * ldh + col0;
                const f32x4 g0 = acc[ai][0][m][0], g1 = acc[ai][0][m][1], u0 = acc[ai][1][m][0], u1 = acc[ai][1][m][1];
                u32x4 w; w.x = cvt_pk_bf16(silu_mul(g0[0], u0[0]), silu_mul(g0[1], u0[1])); w.y = cvt_pk_bf16(silu_mul(g0[2], u0[2]), silu_mul(g0[3], u0[3]));
                w.z = cvt_pk_bf16(silu_mul(g1[0], u1[0]), silu_mul(g1[1], u1[1])); w.w = cvt_pk_bf16(silu_mul(g1[2], u1[2]), silu_mul(g1[3], u1[3]));
                *(u32x4*)rowp = w; }
    }
};
struct EpiResid {
    static constexpr bool PERM = false, AFTER_DRAIN = false;
    const float* base; float* out; int ldc; float scale;
    __device__ __forceinline__ void operator()(const f32x4 (&acc)[2][2][4][2], const Unit& u, int wr, int wc, int fr, int fq) const {
        const int row0 = u.pm * BM + wr * 64 + fr; const int col0 = u.pn * BM + wc * 32 + 4 * fq;
#pragma unroll
        for (int ai = 0; ai < 2; ++ai)
#pragma unroll
            for (int m = 0; m < 4; ++m) { const size_t off = (size_t)(row0 + ai * HALF + m * 16) * ldc + col0;
#pragma unroll
                for (int bj = 0; bj < 2; ++bj)
#pragma unroll
                    for (int n = 0; n < 2; ++n) { const f32x4 b = *(const f32x4*)(base + off + bj * HALF + n * 16); *(f32x4*)(out + off + bj * HALF + n * 16) = b + acc[ai][bj][m][n] * scale; }
                asm volatile("" ::: "memory"); }
    }
};

struct EpiResidNorm {
    static constexpr bool PERM = false, AFTER_DRAIN = true;
    const float* base; float* out; int ldc; float scale; const float* gain; bf16_t* xn; unsigned* xbuf; unsigned* cnt;
    __device__ __forceinline__ void fused(f32x4 (&acc)[2][2][4][2], const Unit& u, int wr, int wc, int fr, int fq, PG8_LAS unsigned char* lds, int wid, int lane) const {
        PG8_LAS float* P = (PG8_LAS float*)lds;
        PG8_LAS float* S = (PG8_LAS float*)(lds + 4096);
        const int col0 = u.pn * BM + wc * 32 + 4 * fq;
#pragma unroll
        for (int ai = 0; ai < 2; ++ai) {
            f32x4 bv[4][2][2];
#pragma unroll
            for (int m = 0; m < 4; ++m) { const size_t off = (size_t)(u.pm * BM + ai * HALF + wr * 64 + m * 16 + fr) * ldc + col0;
#pragma unroll
                for (int bj = 0; bj < 2; ++bj)
#pragma unroll
                    for (int n = 0; n < 2; ++n) bv[m][bj][n] = *(const f32x4*)(base + off + bj * HALF + n * 16); }
            asm volatile("" ::: "memory");
#pragma unroll
            for (int m = 0; m < 4; ++m) { const size_t off = (size_t)(u.pm * BM + ai * HALF + wr * 64 + m * 16 + fr) * ldc + col0; float sq = 0.f;
#pragma unroll
                for (int bj = 0; bj < 2; ++bj)
#pragma unroll
                    for (int n = 0; n < 2; ++n) { const f32x4 v = bv[m][bj][n] + acc[ai][bj][m][n] * scale; acc[ai][bj][m][n] = v;
                        *(f32x4*)(out + off + bj * HALF + n * 16) = v; sq += (v[0] * v[0] + v[1] * v[1]) + (v[2] * v[2] + v[3] * v[3]); }
                sq += __shfl_xor(sq, 16); sq += __shfl_xor(sq, 32);
                if (fq == 0) P[(ai * HALF + wr * 64 + m * 16 + fr) * 4 + wc] = sq; }
            asm volatile("" ::: "memory"); }
        asm volatile("s_waitcnt lgkmcnt(0)" ::: "memory"); __builtin_amdgcn_s_barrier(); asm volatile("" ::: "memory");
        const int row = wid * 32 + (lane & 31);
        if (lane < 32) { const float t = (P[row * 4 + 0] + P[row * 4 + 1]) + (P[row * 4 + 2] + P[row * 4 + 3]);
            __hip_atomic_store(xbuf + ((size_t)(u.pm * BM + row) * 4 + u.pn), __float_as_uint(t), __ATOMIC_RELAXED, __HIP_MEMORY_SCOPE_AGENT); }
        asm volatile("s_waitcnt vmcnt(0)" ::: "memory");
        if (lane == 0) __hip_atomic_fetch_add(cnt + 16 * u.pm, 1u, __ATOMIC_RELAXED, __HIP_MEMORY_SCOPE_AGENT);
        if (wid == 0) {
            unsigned sp = 0;
            while ((unsigned)__builtin_amdgcn_readfirstlane(__hip_atomic_load(cnt + 16 * u.pm, __ATOMIC_RELAXED, __HIP_MEMORY_SCOPE_AGENT)) < 32u) { __builtin_amdgcn_s_sleep(2); if (++sp > (1u << 22)) break; }
            __builtin_amdgcn_fence(__ATOMIC_ACQUIRE, "agent");
        }
        asm volatile("s_waitcnt vmcnt(0) lgkmcnt(0)" ::: "memory"); __builtin_amdgcn_s_barrier(); asm volatile("" ::: "memory");
        if (lane < 32) { const unsigned* slot = xbuf + (size_t)(u.pm * BM + row) * 4; float ss = 0.f;
#pragma unroll
            for (int t = 0; t < 4; ++t) ss += __uint_as_float(__hip_atomic_load(slot + t, __ATOMIC_RELAXED, __HIP_MEMORY_SCOPE_AGENT));
            S[row] = 1.0f / sqrtf(ss * (1.0f / 1024.0f) + 1e-6f); }
        asm volatile("s_waitcnt lgkmcnt(0)" ::: "memory"); __builtin_amdgcn_s_barrier(); asm volatile("" ::: "memory");
        typedef unsigned u32x2v __attribute__((ext_vector_type(2)));
#pragma unroll
        for (int ai = 0; ai < 2; ++ai)
#pragma unroll
            for (int m = 0; m < 4; ++m) { const int r = ai * HALF + wr * 64 + m * 16 + fr; const float rs = S[r]; const size_t off = (size_t)(u.pm * BM + r) * ldc + col0;
#pragma unroll
                for (int bj = 0; bj < 2; ++bj)
#pragma unroll
                    for (int n = 0; n < 2; ++n) { const f32x4 g4 = *(const f32x4*)(gain + col0 + bj * HALF + n * 16); const f32x4 o = acc[ai][bj][m][n] * rs * g4;
                        u32x2v w; w.x = cvt_pk_bf16(o[0], o[1]); w.y = cvt_pk_bf16(o[2], o[3]); *(u32x2v*)(xn + off + bj * HALF + n * 16) = w; } }
    }
};

template <class Epi, class Sched, bool ALIGN_EPI = false, bool SP2 = false>
__device__ __forceinline__ void gemm_phase(PG8_LAS unsigned char* lds, const Gemm g, const Sched& S, const Epi& E) {
    int tid_ = threadIdx.x; asm volatile("" : "+v"(tid_));
    const int tid = tid_, wid = __builtin_amdgcn_readfirstlane(tid >> 6), lane = tid & 63, wr = wid >> 2, wc = wid & 3, fr = lane & 15, fq = lane >> 4;
    const int K = g.K, nt = K / BK;
    unsigned voffA[2], voffB[2];
#pragma unroll
    for (int i = 0; i < 2; ++i) { int R, C; stage_rc(tid * 16 + i * 8192, R, C); const int Rb = Epi::PERM ? ((R & ~31) + perm32(R & 31)) : R;
        voffA[i] = (unsigned)(R * g.lda + C) * 2u; voffB[i] = (unsigned)(Rb * g.ldb + C) * 2u; }
    const size_t kstep = (size_t)(BK * 2);
    const size_t hstepA = (size_t)HALF * g.lda * 2, hstepB = (size_t)HALF * g.ldb * 2;
    const size_t tstepA = 2 * hstepA, tstepB = 2 * hstepB;
    const unsigned ldsw = (unsigned)wid * 1024u;
    const int aoff = lds_byte(wr * 64 + fr, fq * 8), boff = lds_byte(wc * 32 + fr, fq * 8);
#define PG8_SA(b, h) (((b) * 2 + (h)) * HTB)
#define PG8_SB(b, h) ((4 + (b) * 2 + (h)) * HTB)
#define PG8_STAGE(bufoff, gbase, voff) do { _Pragma("unroll") for (int _i = 0; _i < 2; ++_i) \
        __builtin_amdgcn_global_load_lds((const unsigned*)((const char*)(gbase) + (voff)[_i]), (PG8_LAS unsigned*)(lds + (bufoff) + ldsw + _i * 8192), 16, 0, 0); } while (0)
#define PG8_LDA(dst, b, h) do { _Pragma("unroll") for (int m = 0; m < 4; ++m) _Pragma("unroll") for (int k = 0; k < 2; ++k) dst[m][k] = *(const PG8_LAS bf16x8*)(lds + PG8_SA(b, h) + aoff + m * 2048 + k * 1024); } while (0)
#define PG8_LDB(dst, b, h) do { _Pragma("unroll") for (int n = 0; n < 2; ++n) _Pragma("unroll") for (int k = 0; k < 2; ++k) dst[n][k] = *(const PG8_LAS bf16x8*)(lds + PG8_SB(b, h) + boff + n * 2048 + k * 1024); } while (0)
#define PG8_MMA(ai, bj, At, Bt) do { __builtin_amdgcn_s_setprio(1); _Pragma("unroll") for (int m = 0; m < 4; ++m) _Pragma("unroll") for (int n = 0; n < 2; ++n) _Pragma("unroll") for (int k = 0; k < 2; ++k) \
        acc[ai][bj][m][n] = __builtin_amdgcn_mfma_f32_16x16x32_bf16(Bt[n][k], At[m][k], acc[ai][bj][m][n], 0, 0, 0); __builtin_amdgcn_s_setprio(0); } while (0)
#define PG8_WAIT_V(n) asm volatile("s_waitcnt vmcnt(" #n ")" ::: "memory")
#define PG8_WAIT_L(n) asm volatile("s_waitcnt lgkmcnt(" #n ")" ::: "memory")
#define PG8_BAR __builtin_amdgcn_s_barrier()
#define PG8_SCHED __builtin_amdgcn_sched_barrier(0)
    Unit cur, nxt; int ui = 0;
    if (!S.next(0, cur)) return;
    f32x4 acc[2][2][4][2];
#pragma unroll
    for (int a = 0; a < 2; ++a)
#pragma unroll
        for (int b = 0; b < 2; ++b)
#pragma unroll
            for (int m = 0; m < 4; ++m)
#pragma unroll
                for (int n = 0; n < 2; ++n) acc[a][b][m][n] = (f32x4){0.f, 0.f, 0.f, 0.f};
    bf16x8 At[4][2], B0[2][2], B1[2][2];
    const char* cA = (const char*)g.A + (size_t)cur.pm * tstepA; const char* cB = (const char*)g.Bt + (size_t)cur.pn * tstepB;
    S.a_ready(cur);
    if constexpr (SP2) {
        PG8_STAGE(PG8_SB(0, 0), cB, voffB); PG8_STAGE(PG8_SB(0, 1), cB + hstepB, voffB); PG8_STAGE(PG8_SA(0, 0), cA, voffA); PG8_STAGE(PG8_SA(0, 1), cA + hstepA, voffA);
        if (wr == 1) PG8_BAR;
        PG8_WAIT_V(2); PG8_BAR;
        PG8_STAGE(PG8_SB(1, 0), cB + kstep, voffB); PG8_STAGE(PG8_SA(1, 0), cA + kstep, voffA); PG8_STAGE(PG8_SB(1, 1), cB + hstepB + kstep, voffB);
        PG8_WAIT_V(6); PG8_BAR;
    } else {
        PG8_STAGE(PG8_SB(0, 0), cB, voffB); PG8_STAGE(PG8_SA(0, 0), cA, voffA); PG8_STAGE(PG8_SB(0, 1), cB + hstepB, voffB); PG8_STAGE(PG8_SA(0, 1), cA + hstepA, voffA);
        if (wr == 1) PG8_BAR;
        PG8_WAIT_V(4); PG8_BAR;
        PG8_STAGE(PG8_SB(1, 0), cB + kstep, voffB); PG8_STAGE(PG8_SA(1, 0), cA + kstep, voffA); PG8_STAGE(PG8_SB(1, 1), cB + hstepB + kstep, voffB);
        PG8_WAIT_V(6); PG8_BAR;
    }
    for (;;) {
        const bool has_next = S.next(ui + 1, nxt);
        const char* nA = has_next ? (const char*)g.A + (size_t)nxt.pm * tstepA : cA; const char* nB = has_next ? (const char*)g.Bt + (size_t)nxt.pn * tstepB : cB;
        for (int t = 0; t < nt; t += 2) {
            const bool last = (t == nt - 2);
            const char* a1 = cA + (size_t)(t + 1) * kstep;
            const char* a2 = last ? nA : cA + (size_t)(t + 2) * kstep; const char* b2 = last ? nB : cB + (size_t)(t + 2) * kstep;
            const char* a3 = a2 + kstep; const char* b3 = b2 + kstep;
            if (last && has_next) S.a_ready(nxt);
            if constexpr (SP2) {
            PG8_LDB(B0, 0, 0); PG8_LDB(B1, 0, 1); PG8_SCHED; PG8_LDA(At, 0, 0); PG8_STAGE(PG8_SA(1, 1), a1 + hstepA, voffA);
            PG8_WAIT_V(8); PG8_WAIT_L(0); PG8_BAR; PG8_MMA(0, 0, At, B0); PG8_MMA(0, 1, At, B1); PG8_BAR; PG8_SCHED;
            PG8_LDA(At, 0, 1); PG8_STAGE(PG8_SB(0, 0), b2, voffB); PG8_STAGE(PG8_SB(0, 1), b2 + hstepB, voffB); PG8_STAGE(PG8_SA(0, 0), a2, voffA);
            PG8_WAIT_V(8); PG8_WAIT_L(0); PG8_BAR; PG8_MMA(1, 0, At, B0); PG8_MMA(1, 1, At, B1); PG8_BAR; PG8_SCHED;
            PG8_LDB(B0, 1, 0); PG8_LDB(B1, 1, 1); PG8_SCHED; PG8_LDA(At, 1, 0); PG8_STAGE(PG8_SA(0, 1), a2 + hstepA, voffA);
            PG8_WAIT_V(8); PG8_WAIT_L(0); PG8_BAR; PG8_MMA(0, 0, At, B0); PG8_MMA(0, 1, At, B1); PG8_BAR; PG8_SCHED;
            PG8_LDA(At, 1, 1); PG8_STAGE(PG8_SB(1, 0), b3, voffB); PG8_STAGE(PG8_SB(1, 1), b3 + hstepB, voffB); PG8_STAGE(PG8_SA(1, 0), a3, voffA);
            PG8_WAIT_V(8); PG8_WAIT_L(0); PG8_BAR; PG8_MMA(1, 0, At, B0); PG8_MMA(1, 1, At, B1); PG8_BAR; PG8_SCHED;
            } else {
            PG8_LDB(B0, 0, 0); PG8_SCHED; PG8_LDA(At, 0, 0); PG8_STAGE(PG8_SA(1, 1), a1 + hstepA, voffA);
            PG8_WAIT_L(8); PG8_BAR; PG8_WAIT_L(0); PG8_MMA(0, 0, At, B0); PG8_BAR; PG8_SCHED;
            PG8_LDB(B1, 0, 1); PG8_STAGE(PG8_SB(0, 0), b2, voffB);
            PG8_BAR; PG8_WAIT_L(0); PG8_MMA(0, 1, At, B1); PG8_BAR;
            PG8_LDA(At, 0, 1); PG8_STAGE(PG8_SA(0, 0), a2, voffA);
            PG8_BAR; PG8_WAIT_L(0); PG8_MMA(1, 0, At, B0); PG8_BAR; PG8_SCHED;
            PG8_STAGE(PG8_SB(0, 1), b2 + hstepB, voffB);
            PG8_WAIT_V(6); PG8_BAR; PG8_MMA(1, 1, At, B1); PG8_BAR;
            PG8_LDB(B0, 1, 0); PG8_SCHED; PG8_LDA(At, 1, 0); PG8_STAGE(PG8_SA(0, 1), a2 + hstepA, voffA);
            PG8_WAIT_L(8); PG8_BAR; PG8_WAIT_L(0); PG8_MMA(0, 0, At, B0); PG8_BAR; PG8_SCHED;
            PG8_LDB(B1, 1, 1); PG8_STAGE(PG8_SB(1, 0), b3, voffB);
            PG8_BAR; PG8_WAIT_L(0); PG8_MMA(0, 1, At, B1); PG8_BAR;
            PG8_LDA(At, 1, 1); PG8_STAGE(PG8_SA(1, 0), a3, voffA);
            PG8_BAR; PG8_WAIT_L(0); PG8_MMA(1, 0, At, B0); PG8_BAR; PG8_SCHED;
            PG8_STAGE(PG8_SB(1, 1), b3 + hstepB, voffB);
            PG8_WAIT_V(6); PG8_BAR; PG8_MMA(1, 1, At, B1); PG8_BAR;
            }
        }
        if constexpr (ALIGN_EPI) { if (wr == 0) PG8_BAR; }
        if constexpr (!Epi::AFTER_DRAIN) { E(acc, cur, wr, wc, fr, fq); S.done(cur); }
        if (!has_next) break;
#pragma unroll
        for (int a = 0; a < 2; ++a)
#pragma unroll
            for (int b = 0; b < 2; ++b)
#pragma unroll
                for (int m = 0; m < 4; ++m)
#pragma unroll
                    for (int n = 0; n < 2; ++n) acc[a][b][m][n] = (f32x4){0.f, 0.f, 0.f, 0.f};
        cur = nxt; cA = nA; cB = nB; ++ui;
        if constexpr (ALIGN_EPI) { if (wr == 1) PG8_BAR; }
    }
    PG8_WAIT_V(0);
    if constexpr (!ALIGN_EPI) { if (wr == 0) PG8_BAR; }
    PG8_BAR;
    if constexpr (Epi::AFTER_DRAIN) { E.fused(acc, cur, wr, wc, fr, fq, lds, wid, lane); S.done(cur); }
#undef PG8_SA
#undef PG8_SB
#undef PG8_STAGE
#undef PG8_LDA
#undef PG8_LDB
#undef PG8_MMA
#undef PG8_WAIT_V
#undef PG8_WAIT_L
#undef PG8_BAR
#undef PG8_SCHED
}
}

#define LAS __attribute__((address_space(3)))
typedef unsigned short bf16_t;
typedef short bf16x8 __attribute__((ext_vector_type(8)));
typedef short s16x4 __attribute__((ext_vector_type(4)));
typedef float f32x4 __attribute__((ext_vector_type(4)));
typedef float f32x16 __attribute__((ext_vector_type(16)));
typedef unsigned u32x4 __attribute__((ext_vector_type(4)));
typedef unsigned u32x2 __attribute__((ext_vector_type(2)));

constexpr int DM = 1024, DFF = 2816, MG = 16384;
constexpr int EVN = 1792, EVN_REAL = 1568, ODN = 2304, ODN_PAD = 2432;
constexpr float EPS = 1e-6f, LOG2E = 1.4426950408889634f;
constexpr float LAM_INIT = 0.35550906f;
constexpr size_t MiB = 1u << 20;
constexpr size_t WS_CTL = 0, WS_T32C = 1 * MiB, WS_T32S = 2 * MiB, WS_T16C = 3 * MiB, WS_T16S = 3 * MiB + 512 * 1024;
constexpr size_t WS_FFN_IN = 4 * MiB, FFN_IN_BYTES = 11 * MiB, WS_FFN_OUT = WS_FFN_IN + 4 * FFN_IN_BYTES, FFN_OUT_BYTES = 5 * MiB + 512 * 1024;
constexpr size_t WS_EV_IN = 70 * MiB, WS_UQ = WS_EV_IN + (size_t)EVN * 1024 * 2, WS_UK = WS_UQ + 768 * 512 * 2, WS_UV = WS_UK + 512 * 256 * 2, WS_EV_OUT = WS_UV + 512 * 256 * 2;
constexpr size_t WS_OD_IN = WS_EV_OUT + 2 * MiB, WS_OD_OUT = WS_OD_IN + (size_t)ODN_PAD * 1024 * 2, WS_W_END = WS_OD_OUT + 2 * MiB;
static_assert(WS_W_END <= 84 * MiB, "weights");
constexpr size_t WS_XN = 84 * MiB;
constexpr size_t WS_R = 116 * MiB;
constexpr size_t WS_H = WS_R;
constexpr size_t WS_Z = WS_R;
constexpr size_t WS_VTA = WS_R + 56 * MiB, WS_QB = WS_R + 64 * MiB, WS_KNOPE = WS_R + 88 * MiB, WS_KB = WS_R + 104 * MiB, WS_VTB = WS_R + 128 * MiB;
constexpr size_t WS_VTC = WS_R + 72 * MiB, WS_VTD = WS_R + 88 * MiB, WS_O1 = WS_R + 96 * MiB;
constexpr size_t WS_END = WS_R + 160 * MiB;
constexpr int LDS_BYTES = 147456, MISC_OFF = 131072;

__device__ __forceinline__ float bf2f(bf16_t h) { return __uint_as_float((unsigned)h << 16); }
__device__ __forceinline__ unsigned f2bf(float f) { unsigned u = __float_as_uint(f); return (u + 0x7fffu + ((u >> 16) & 1u)) >> 16; }
__device__ __forceinline__ unsigned pk2(float lo, float hi) { return f2bf(lo) | (f2bf(hi) << 16); }
__device__ __forceinline__ float wave_sum(float v) {
#pragma unroll
    for (int o = 1; o < 64; o <<= 1) v += __shfl_xor(v, o);
    return v;
}
__device__ __forceinline__ float swap32_max(float v) { auto rr = __builtin_amdgcn_permlane32_swap(__float_as_uint(v), __float_as_uint(v), false, false); return fmaxf(__uint_as_float(rr[0]), __uint_as_float(rr[1])); }
__device__ __forceinline__ float swap32_sum(float v) { auto rr = __builtin_amdgcn_permlane32_swap(__float_as_uint(v), __float_as_uint(v), false, false); return __uint_as_float(rr[0]) + __uint_as_float(rr[1]); }
__device__ __forceinline__ unsigned cvtpk(float lo, float hi) { typedef float f2 __attribute__((ext_vector_type(2))); typedef __bf16 b2 __attribute__((ext_vector_type(2))); f2 v = {lo, hi}; b2 b = __builtin_convertvector(v, b2); return __builtin_bit_cast(unsigned, b); }

#define XB_TMO      128
#define XB_XCNT(j)  (256  + 64 * (j))
#define XB_XSUB(j)  (1280 + 64 * (j))
#define XB_XGEN(j)  (2304 + 64 * (j))
#define XB_TOP      3328
#define XB_TOPGEN   3392
#define XCD_BAR_WORDS 3456
#define XB_SPIN_CAP (1u << 18)

__device__ __forceinline__ unsigned xb_ld(unsigned* p)              { return __hip_atomic_load(p, __ATOMIC_RELAXED, __HIP_MEMORY_SCOPE_AGENT); }
__device__ __forceinline__ unsigned xb_add(unsigned* p, unsigned v) { return __hip_atomic_fetch_add(p, v, __ATOMIC_RELAXED, __HIP_MEMORY_SCOPE_AGENT); }
__device__ __forceinline__ unsigned xb_xcc_id() { return (unsigned)__builtin_amdgcn_s_getreg((3 << 11) | 20) & 0xFu; }
#define XB_SPIN(cond, bar) do { unsigned _sp = 0; while (cond) { __builtin_amdgcn_s_sleep(1); \
    if ((++_sp & 255u) == 0u) { if (xb_ld(&(bar)[XB_TMO])) break; if (_sp > XB_SPIN_CAP) { atomicAdd(&(bar)[XB_TMO], 1u); break; } } } } while (0)

struct XcdBarrier {
    unsigned* bar; unsigned x;
    volatile LAS unsigned* st;
};

__device__ __forceinline__ XcdBarrier xcd_barrier_post(unsigned* bar, volatile LAS unsigned* st) {
    XcdBarrier b; b.bar = bar; b.x = xb_xcc_id(); b.st = st;
    if (threadIdx.x == 0) (void)xb_add(&bar[XB_XCNT(b.x)], 1u);
    return b;
}
__device__ __forceinline__ void xcd_barrier_complete(unsigned* bar, unsigned x, unsigned& nloc, unsigned& nx) {
    const unsigned G = gridDim.x * gridDim.y * gridDim.z;
    unsigned sum, cnt, mine, sp = 0u;
    for (;;) {
        sum = 0u; cnt = 0u; mine = 0u;
#pragma unroll
        for (unsigned j = 0; j < 16; ++j) { const unsigned c = xb_ld(&bar[XB_XCNT(j)]); sum += c; cnt += (c > 0u) ? 1u : 0u; mine = (j == x) ? c : mine; }
        if (sum == G) break;
        __builtin_amdgcn_s_sleep(1);
        if ((++sp & 255u) == 0u) { if (xb_ld(&bar[XB_TMO])) break; if (sp > XB_SPIN_CAP) { atomicAdd(&bar[XB_TMO], 1u); break; } }
    }
    nloc = mine > 0u ? mine : 1u; nx = cnt > 0u ? cnt : 1u;
}

__device__ __forceinline__ void xcd_barrier(const XcdBarrier& b) {
    asm volatile("s_waitcnt vmcnt(0)" ::: "memory");
    __syncthreads();
    if (threadIdx.x == 0) {
        unsigned* bar = b.bar;
        __builtin_amdgcn_s_waitcnt(0);
        unsigned nloc = b.st[0], nx = b.st[1];
        if (nloc == 0u) { xcd_barrier_complete(bar, b.x, nloc, nx); b.st[0] = nloc; b.st[1] = nx; }
        const unsigned old = xb_add(&bar[XB_XSUB(b.x)], 1u);
        const unsigned gen = old / nloc;
        if (old + 1u == (gen + 1u) * nloc) {
            __builtin_amdgcn_fence(__ATOMIC_RELEASE, "agent");
            asm volatile("s_waitcnt vmcnt(0)" ::: "memory");
            const unsigned og = xb_add(&bar[XB_TOP], 1u);
            const unsigned tg = og / nx;
            if (og + 1u == (tg + 1u) * nx) xb_add(&bar[XB_TOPGEN], 1u);
            else XB_SPIN(xb_ld(&bar[XB_TOPGEN]) == tg, bar);
            __builtin_amdgcn_fence(__ATOMIC_ACQUIRE, "agent");
            xb_add(&bar[XB_XGEN(b.x)], 1u);
            asm volatile("s_waitcnt vmcnt(0)" ::: "memory");
        } else {
            XB_SPIN(xb_ld(&bar[XB_XGEN(b.x)]) == gen, bar);
            __builtin_amdgcn_fence(__ATOMIC_ACQUIRE, "agent");
            asm volatile("s_waitcnt vmcnt(0)" ::: "memory");
        }
    }
    __syncthreads();
}

__device__ __forceinline__ float max3f(float a, float b, float c) { float r; asm("v_max3_f32 %0, %1, %2, %3" : "=v"(r) : "v"(a), "v"(b), "v"(c)); return r; }
typedef float f32x2 __attribute__((ext_vector_type(2)));
template <int DQK, int DV, bool WIN, int NQ, bool DEEP = false, bool FIXM = false>
__device__ __forceinline__ void attn_core(LAS unsigned char* lds, const bf16_t* qrowp, int ldq, const bf16_t* Kp, int ldk, const bf16_t* Vtp, int ldv, int kbeg, int kend, int qtok,
                                          f32x16 (&o)[NQ][DV / 32], float (&m_out)[NQ], float (&l_out)[NQ], float sbound = 0.f) {
    constexpr int KROW = DQK * 2 + 16, KT = 64 * KROW, VROW = 144, VT = DV * VROW, BUF = KT + VT;
    constexpr int KCH = DQK / 8, NKC = 64 * KCH, NKL = (NKC + 511) / 512, NVL = DV / 64;
    constexpr float THR = 8.0f;
    int tid_ = threadIdx.x; asm volatile("" : "+v"(tid_));
    const int tid = tid_, lane = tid & 63, r32 = lane & 31, hi = lane >> 5;
    const int wq0 = __builtin_amdgcn_readfirstlane(qtok - r32);
    bf16x8 qf[NQ][DQK / 16];
#pragma unroll
    for (int g = 0; g < NQ; ++g)
#pragma unroll
        for (int s = 0; s < DQK / 16; ++s) qf[g][s] = *(const bf16x8*)(qrowp + (size_t)(32 * g) * ldq + 16 * s + 8 * hi);
    float m[NQ], l[NQ];
#pragma unroll
    for (int g = 0; g < NQ; ++g) { m[g] = FIXM ? sbound : -1e30f; l[g] = 0.f;
#pragma unroll
        for (int db = 0; db < DV / 32; ++db)
#pragma unroll
            for (int r = 0; r < 16; ++r) o[g][db][r] = 0.f; }
    u32x4 kst[2][NKL], vst[2][NVL];
    const int nt = (kend - kbeg) >> 6;
#define AT_GLOAD(set, t) do { const int key0_ = kbeg + 64 * (t); \
        _Pragma("unroll") for (int i_ = 0; i_ < NKL; ++i_) { const int c_ = tid + 512 * i_; if ((NKC % 512 == 0) || c_ < NKC) { const int row_ = c_ / KCH, cc_ = c_ % KCH; kst[set][i_] = *(const u32x4*)(Kp + (size_t)(key0_ + row_) * ldk + cc_ * 8); } } \
        _Pragma("unroll") for (int i_ = 0; i_ < NVL; ++i_) { const int c_ = tid + 512 * i_; const int d_ = c_ >> 3, cc_ = c_ & 7; vst[set][i_] = *(const u32x4*)(Vtp + (size_t)d_ * ldv + key0_ + cc_ * 8); } } while (0)
#define AT_LSTORE(set, buf) do { LAS unsigned char* B_ = lds + (buf) * BUF; \
        _Pragma("unroll") for (int i_ = 0; i_ < NKL; ++i_) { const int c_ = tid + 512 * i_; if ((NKC % 512 == 0) || c_ < NKC) { const int row_ = c_ / KCH, cc_ = c_ % KCH; *(LAS u32x4*)(B_ + row_ * KROW + cc_ * 16) = kst[set][i_]; } } \
        _Pragma("unroll") for (int i_ = 0; i_ < NVL; ++i_) { const int c_ = tid + 512 * i_; const int d_ = c_ >> 3, cc_ = c_ & 7; LAS unsigned char* p_ = B_ + KT + d_ * VROW + (cc_ >> 1) * 32 + (cc_ & 1) * 8; \
            *(LAS u32x2*)p_ = (u32x2){vst[set][i_].x, vst[set][i_].y}; *(LAS u32x2*)(p_ + 16) = (u32x2){vst[set][i_].z, vst[set][i_].w}; } } while (0)
    constexpr int NLD = NKL + NVL;
#define AT_GLOAD_ASM(set, t) do { const int key0_ = kbeg + 64 * (t); \
        _Pragma("unroll") for (int i_ = 0; i_ < NKL; ++i_) { int c_ = tid + 512 * i_; if (c_ > NKC - 1) c_ = NKC - 1; const int row_ = c_ / KCH, cc_ = c_ % KCH; const bf16_t* gp_ = Kp + (size_t)(key0_ + row_) * ldk + cc_ * 8; \
            asm volatile("global_load_dwordx4 %0, %1, off" : "=&v"(kst[set][i_]) : "v"(gp_)); } \
        _Pragma("unroll") for (int i_ = 0; i_ < NVL; ++i_) { const int c_ = tid + 512 * i_; const int d_ = c_ >> 3, cc_ = c_ & 7; const bf16_t* gp_ = Vtp + (size_t)d_ * ldv + key0_ + cc_ * 8; \
            asm volatile("global_load_dwordx4 %0, %1, off" : "=&v"(vst[set][i_]) : "v"(gp_)); } } while (0)
#define AT_WAITV(n) asm volatile("s_waitcnt vmcnt(%0)" :: "n"(n) : "memory")
    if (DEEP) { AT_GLOAD_ASM(0, 0); AT_GLOAD_ASM(1, 1); } else AT_GLOAD(0, 0);
#pragma unroll
    for (int g = 0; g < NQ; ++g)
#pragma unroll
        for (int s = 0; s < DQK / 16; ++s) asm volatile("" : "+v"(qf[g][s]));
    if (DEEP) AT_WAITV(NLD);
    AT_LSTORE(0, 0);
    __syncthreads();
    for (int t0 = 0; t0 < nt; t0 += (DEEP ? 2 : 1)) {
#pragma unroll
      for (int hf = 0; hf < (DEEP ? 2 : 1); ++hf) {
        const int t = t0 + hf;
        if (DEEP) { if (t + 2 < nt) AT_GLOAD_ASM(hf, t + 2); } else { if (t + 1 < nt) AT_GLOAD(0, t + 1); }
        const int key0 = kbeg + 64 * t;
        bool live = true;
        if (WIN) live = !(key0 + 63 < wq0 - 128 || key0 > wq0 + 32 * NQ - 1 + 128);
        if (live) {
            LAS unsigned char* B = lds + (t & 1) * BUF;
            f32x16 p[NQ][2];
            const float ci = 0.f;
            const f32x16 zero16 = {ci, ci, ci, ci, ci, ci, ci, ci, ci, ci, ci, ci, ci, ci, ci, ci};
            constexpr int NS = DQK / 16, NDB = DV / 32, NVF = 4 * NDB, NFR = (NVF > 8 ? NVF : 8);
            static_assert(NQ == 1 || NVF <= 8, "two row groups only with v dim 64");
            bf16x8 fr[NFR];
#define AT_SBAR() __builtin_amdgcn_sched_barrier(0)
#pragma unroll
            for (int s0 = 0; s0 < NS; s0 += 4) {
#pragma unroll
                for (int s2 = 0; s2 < 4; ++s2) if (s0 + s2 < NS) {
                    fr[2 * s2] = *(const LAS bf16x8*)(B + r32 * KROW + (16 * (s0 + s2) + 8 * hi) * 2);
                    fr[2 * s2 + 1] = *(const LAS bf16x8*)(B + (32 + r32) * KROW + (16 * (s0 + s2) + 8 * hi) * 2); }
                AT_SBAR();
#pragma unroll
                for (int s2 = 0; s2 < 4; ++s2) if (s0 + s2 < NS) {
#pragma unroll
                    for (int g = 0; g < NQ; ++g) {
                        p[g][0] = __builtin_amdgcn_mfma_f32_32x32x16_bf16(fr[2 * s2], qf[g][s0 + s2], (s0 + s2) == 0 ? zero16 : p[g][0], 0, 0, 0);
                        p[g][1] = __builtin_amdgcn_mfma_f32_32x32x16_bf16(fr[2 * s2 + 1], qf[g][s0 + s2], (s0 + s2) == 0 ? zero16 : p[g][1], 0, 0, 0); } }
                AT_SBAR();
            }
#define AT_VLOAD() do { _Pragma("unroll") for (int j_ = 0; j_ < 4; ++j_) _Pragma("unroll") for (int db_ = 0; db_ < NDB; ++db_) { fr[j_ * NDB + db_] = *(const LAS bf16x8*)(B + KT + (32 * db_ + r32) * VROW + 32 * j_ + 16 * hi); } AT_SBAR(); } while (0)
            if (NQ == 1) AT_VLOAD();
#pragma unroll
            for (int g = 0; g < NQ; ++g) {
                if (WIN) {
                    const int kb = key0 + 4 * hi - (qtok + 32 * g);
#pragma unroll
                    for (int r = 0; r < 16; ++r) { const int d0 = kb + (r & 3) + 8 * (r >> 2), d1 = d0 + 32;
                        if (d0 > 128 || d0 < -128) p[g][0][r] = -1e30f;
                        if (d1 > 128 || d1 < -128) p[g][1][r] = -1e30f; }
                }
                if constexpr (FIXM) {
                    f32x2 sum2 = {0.f, 0.f};
#pragma unroll
                    for (int h2 = 0; h2 < 2; ++h2)
#pragma unroll
                        for (int r = 0; r < 16; r += 2) { const f32x2 d2 = (f32x2){p[g][h2][r], p[g][h2][r + 1]} - (f32x2){sbound, sbound}; f32x2 e2; e2.x = __builtin_amdgcn_exp2f(d2.x); e2.y = __builtin_amdgcn_exp2f(d2.y); p[g][h2][r] = e2.x; p[g][h2][r + 1] = e2.y; sum2 += e2; }
                    l[g] += sum2.x + sum2.y;
                } else {
                if (!WIN) asm volatile("s_nop 15\n\ts_nop 7" : "+v"(p[g][0]), "+v"(p[g][1]));
                float mxa = max3f(p[g][0][0], p[g][1][0], p[g][0][1]), mxb = max3f(p[g][1][1], p[g][0][2], p[g][1][2]);
#pragma unroll
                for (int r = 3; r < 15; r += 2) { mxa = max3f(mxa, p[g][0][r], p[g][1][r]); mxb = max3f(mxb, p[g][0][r + 1], p[g][1][r + 1]); }
                float mx = max3f(mxa, mxb, max3f(p[g][0][15], p[g][1][15], p[g][0][15]));
                mx = swap32_max(mx);
                if (__any(mx > m[g] + THR)) {
                    const float mn = fmaxf(m[g], mx), alpha = __builtin_amdgcn_exp2f(m[g] - mn);
                    m[g] = mn; l[g] *= alpha;
#pragma unroll
                    for (int db = 0; db < NDB; ++db)
#pragma unroll
                        for (int r = 0; r < 16; ++r) o[g][db][r] *= alpha;
                }
                const float mr = m[g];
                f32x2 sum2 = {0.f, 0.f}; const f32x2 mr2 = {mr, mr};
#pragma unroll
                for (int h2 = 0; h2 < 2; ++h2)
#pragma unroll
                    for (int r = 0; r < 16; r += 2) { const f32x2 d2 = (f32x2){p[g][h2][r], p[g][h2][r + 1]} - mr2; f32x2 e2; e2.x = __builtin_amdgcn_exp2f(d2.x); e2.y = __builtin_amdgcn_exp2f(d2.y);
                        p[g][h2][r] = e2.x; p[g][h2][r + 1] = e2.y; sum2 += e2; }
                l[g] += sum2.x + sum2.y;
                }
            }
            if (FIXM) AT_SBAR();
            if (NQ != 1) AT_VLOAD();
#pragma unroll
            for (int j = 0; j < 4; ++j) {
                bf16x8 pb[NQ];
#pragma unroll
                for (int g = 0; g < NQ; ++g) { const int b2 = 8 * (j & 1); const f32x16& ps = p[g][j >> 1];
                    u32x4 pw; pw.x = cvtpk(ps[b2], ps[b2 + 1]); pw.y = cvtpk(ps[b2 + 2], ps[b2 + 3]); pw.z = cvtpk(ps[b2 + 4], ps[b2 + 5]); pw.w = cvtpk(ps[b2 + 6], ps[b2 + 7]);
                    pb[g] = __builtin_bit_cast(bf16x8, pw); }
#pragma unroll
                for (int db = 0; db < NDB; ++db)
#pragma unroll
                    for (int g = 0; g < NQ; ++g) o[g][db] = __builtin_amdgcn_mfma_f32_32x32x16_bf16(fr[j * NDB + db], pb[g], o[g][db], 0, 0, 0);
            }
            AT_SBAR();
#undef AT_SBAR
#undef AT_VLOAD
        }
        if (DEEP) { if (t + 2 < nt) AT_WAITV(NLD); else AT_WAITV(0); if (t + 1 < nt) AT_LSTORE(1 - hf, 1 - hf); } else { if (t + 1 < nt) AT_LSTORE(0, (t + 1) & 1); }
        __syncthreads();
      }
    }
#undef AT_GLOAD
#undef AT_GLOAD_ASM
#undef AT_WAITV
#undef AT_LSTORE
#pragma unroll
    for (int g = 0; g < NQ; ++g) { m_out[g] = m[g]; l_out[g] = l[g]; }
}
template <int DV>
__device__ __forceinline__ void store_o(const f32x16 (&o)[DV / 32], float scale, bf16_t* dst, int hi) {
#pragma unroll
    for (int db = 0; db < DV / 32; ++db)
#pragma unroll
        for (int rq = 0; rq < 4; ++rq) {
            u32x2 w; w.x = cvtpk(o[db][4 * rq] * scale, o[db][4 * rq + 1] * scale); w.y = cvtpk(o[db][4 * rq + 2] * scale, o[db][4 * rq + 3] * scale);
            *(u32x2*)(dst + 32 * db + 8 * rq + 4 * hi) = w;
        }
}

__device__ __forceinline__ void rownorm_rows(const float* x, const float* g, bf16_t* xn, int gw, int NGW, int lane) {
    const f32x4* gr = (const f32x4*)g + lane;
    f32x4 gg[4], nx[4];
#pragma unroll
    for (int j = 0; j < 4; ++j) { gg[j] = gr[64 * j]; nx[j] = ((const f32x4*)(x + (size_t)gw * DM) + lane)[64 * j]; }
    for (int r = gw; r < MG; r += NGW) {
        f32x4 v[4]; float s = 0.f;
#pragma unroll
        for (int j = 0; j < 4; ++j) { v[j] = nx[j]; s += (v[j].x * v[j].x + v[j].y * v[j].y) + (v[j].z * v[j].z + v[j].w * v[j].w); }
        if (r + NGW < MG) {
#pragma unroll
            for (int j = 0; j < 4; ++j) nx[j] = ((const f32x4*)(x + (size_t)(r + NGW) * DM) + lane)[64 * j]; }
        const float rs = 1.0f / sqrtf(wave_sum(s) * (1.f / DM) + EPS);
        unsigned long long* o8 = (unsigned long long*)(xn + (size_t)r * DM) + lane;
#pragma unroll
        for (int j = 0; j < 4; ++j) o8[64 * j] = (unsigned long long)pk2(v[j].x * rs * gg[j].x, v[j].y * rs * gg[j].y) | ((unsigned long long)pk2(v[j].z * rs * gg[j].z, v[j].w * rs * gg[j].w) << 32);
    }
}
__device__ __forceinline__ float wave_max(float v) {
#pragma unroll
    for (int o = 1; o < 64; o <<= 1) v = fmaxf(v, __shfl_xor(v, o));
    return __uint_as_float(__builtin_amdgcn_readfirstlane(__float_as_uint(v)));
}
template <int N> __device__ __forceinline__ void wave_sum_n(float (&v)[N]) {
#pragma unroll
    for (int o = 1; o < 64; o <<= 1)
#pragma unroll
        for (int i = 0; i < N; ++i) v[i] += __shfl_xor(v[i], o);
}
template <int MODE>
__device__ __forceinline__ void head64_norm_rope(bf16_t* p, const float* g, const float* tc, const float* ts, int pos, float oscale, int lane) {
    const float v = bf2f(p[lane]);
    const float rs = 1.0f / sqrtf(wave_sum(v * v) * (1.f / 64.f) + EPS);
    const float y = v * rs * g[lane];
    float out;
    if (MODE == 0) { const float pr = __shfl_xor(y, 32); const int i = lane & 31; const float c = tc[pos * 32 + i], s = ts[pos * 32 + i]; out = (lane < 32) ? (y * c - pr * s) : (pr * s + y * c); }
    else { const float pr = __shfl_xor(y, 16); const int i = lane & 15; const int pp = (lane < 32) ? (pos >> 6) : (pos & 63); const float c = tc[pp * 16 + i], s = ts[pp * 16 + i]; out = ((lane & 16) == 0) ? (y * c - pr * s) : (pr * s + y * c); }
    p[lane] = (bf16_t)f2bf(out * oscale);
}
__device__ __forceinline__ void head96_norm_rope(const bf16_t* src1, const bf16_t* src2, bf16_t* dst, const float* g, const float* tc, const float* ts, int pos, float oscale, int lane) {
    const float v1 = bf2f(src1[lane]); const float v2 = (lane < 32) ? bf2f(src2[lane]) : 0.f;
    const float rs = 1.0f / sqrtf(wave_sum(v1 * v1 + v2 * v2) * (1.f / 96.f) + EPS);
    const float y1 = v1 * rs * g[lane], y2 = v2 * rs * g[64 + (lane & 31)];
    const float pr = __shfl_xor(y2, 16); const int i = lane & 15; const float c = tc[pos * 16 + i], s = ts[pos * 16 + i];
    const float o2 = ((lane & 16) == 0) ? (y2 * c - pr * s) : (pr * s + y2 * c);
    dst[lane] = (bf16_t)f2bf(y1 * oscale);
    if (lane < 32) dst[64 + lane] = (bf16_t)f2bf(o2 * oscale);
}

__device__ __forceinline__ void titem_load(const float* W, int N, int k0, int n0, int lane, float (&wv)[32]) {
#pragma unroll
    for (int i = 0; i < 32; ++i) { const int kk = 2 * i + (lane >> 5); wv[i] = W[(size_t)(k0 + kk) * N + n0 + (lane & 31)]; }
}
__device__ __forceinline__ void titem_store(const float (&wv)[32], int K, bf16_t* WT, int drow, LAS float* scr, int k0, int lane) {
#pragma unroll
    for (int i = 0; i < 32; ++i) { const int kk = 2 * i + (lane >> 5); scr[kk * 33 + (lane & 31)] = wv[i]; }
    asm volatile("s_waitcnt lgkmcnt(0)" ::: "memory");
    const int c = lane & 7;
#pragma unroll
    for (int j = 0; j < 4; ++j) { const int n = (lane >> 3) + 8 * j; const LAS float* s = scr + (8 * c) * 33 + n;
        u32x4 o; o.x = pk2(s[0 * 33], s[1 * 33]); o.y = pk2(s[2 * 33], s[3 * 33]); o.z = pk2(s[4 * 33], s[5 * 33]); o.w = pk2(s[6 * 33], s[7 * 33]);
        *(u32x4*)(WT + (size_t)(drow + n) * K + k0 + 8 * c) = o; }
    asm volatile("s_waitcnt lgkmcnt(0)" ::: "memory");
}
__device__ __forceinline__ void convert_matrix(const float* W, int K, int N, bf16_t* WT, bf16_t* WT2, int mode, LAS float* scr, int gw, int NGW, int lane) {
    const int nblk = N / 32, nitems = (K / 64) * nblk;
    float wn[32];
    if (gw < nitems) titem_load(W, N, 64 * (gw / nblk), 32 * (gw % nblk), lane, wn);
    for (int it = gw; it < nitems; it += NGW) {
        const int kb = it / nblk, nb = it % nblk, n0 = 32 * nb; int drow = n0; bf16_t* dst = WT;
        if (mode == 1) { if (n0 < DFF) drow = 256 * (n0 / 128) + (n0 % 128); else { const int u = n0 - DFF; drow = 256 * (u / 128) + 128 + (u % 128); } }
        else if (mode == 2) { const int h = n0 / 128, w = n0 % 128; if (w < 64) drow = h * 64 + w; else { dst = WT2; drow = h * 64 + w - 64; } }
        float wc[32];
#pragma unroll
        for (int i = 0; i < 32; ++i) wc[i] = wn[i];
        const int it2 = it + NGW;
        if (it2 < nitems) titem_load(W, N, 64 * (it2 / nblk), 32 * (it2 % nblk), lane, wn);
        titem_store(wc, K, dst, drow, scr, 64 * kb, lane);
    }
}

__constant__ float INV32[32] = {1.0f, 0.7498942613601685f, 0.5623413324356079f, 0.4216965138912201f, 0.3162277638912201f, 0.23713737726211548f, 0.17782793939113617f, 0.133352130651474f, 0.10000000149011612f, 0.07498941570520401f, 0.05623413249850273f, 0.04216965287923813f, 0.03162277489900589f, 0.023713737726211548f, 0.017782794311642647f, 0.01333521492779255f, 0.009999999776482582f, 0.007498941849917173f, 0.005623413249850273f, 0.0042169648222625256f, 0.003162277629598975f, 0.00237137358635664f, 0.0017782794311642647f, 0.0013335214462131262f, 0.0010000000474974513f, 0.0007498942431993783f, 0.000562341301701963f, 0.0004216965171508491f, 0.0003162277571391314f, 0.00023713737027719617f, 0.00017782794020604342f, 0.0001333521504420787f};
__constant__ float INV16[16] = {1.0f, 0.5623413324356079f, 0.3162277638912201f, 0.17782793939113617f, 0.10000000149011612f, 0.05623413249850273f, 0.03162277489900589f, 0.017782794311642647f, 0.009999999776482582f, 0.005623413249850273f, 0.003162277629598975f, 0.0017782794311642647f, 0.0010000000474974513f, 0.000562341301701963f, 0.0003162277571391314f, 0.00017782794020604342f};
struct Args { const float* in[29]; float* out; unsigned char* ws; };

__global__ void __launch_bounds__(512) hybrid_fwd(Args a) {
    extern __shared__ __attribute__((aligned(16))) unsigned char lds_raw[];
    LAS unsigned char* lds = (LAS unsigned char*)lds_raw;
    cg::grid_group grid = cg::this_grid();
    const int tid = threadIdx.x, lane = tid & 63, wid = __builtin_amdgcn_readfirstlane(tid >> 6);
    const int G = gridDim.x, gw = blockIdx.x * 8 + wid, NGW = G * 8;
#define ctl ((unsigned*)(a.ws + WS_CTL))
#define T32C ((float*)(a.ws + WS_T32C))
#define T32S ((float*)(a.ws + WS_T32S))
#define T16C ((float*)(a.ws + WS_T16C))
#define T16S ((float*)(a.ws + WS_T16S))
#define XN ((bf16_t*)(a.ws + WS_XN))
#define HB ((bf16_t*)(a.ws + WS_H))
#define Z ((bf16_t*)(a.ws + WS_Z))
#define W_EV_IN ((bf16_t*)(a.ws + WS_EV_IN))
#define W_UQ ((bf16_t*)(a.ws + WS_UQ))
#define W_UK ((bf16_t*)(a.ws + WS_UK))
#define W_UV ((bf16_t*)(a.ws + WS_UV))
#define W_EV_OUT ((bf16_t*)(a.ws + WS_EV_OUT))
#define W_OD_IN ((bf16_t*)(a.ws + WS_OD_IN))
#define W_OD_OUT ((bf16_t*)(a.ws + WS_OD_OUT))
#define VTA ((bf16_t*)(a.ws + WS_VTA))
#define QB ((bf16_t*)(a.ws + WS_QB))
#define KNOPE ((bf16_t*)(a.ws + WS_KNOPE))
#define KB ((bf16_t*)(a.ws + WS_KB))
#define VTB ((bf16_t*)(a.ws + WS_VTB))
#define VTC ((bf16_t*)(a.ws + WS_VTC))
#define VTD ((bf16_t*)(a.ws + WS_VTD))
#define O1 ((float*)(a.ws + WS_O1))
#define XBUF ((unsigned*)(a.ws + WS_CTL + 512 * 1024))
    volatile LAS unsigned* misc = (volatile LAS unsigned*)(lds + MISC_OFF);
    if (threadIdx.x < 16) misc[threadIdx.x] = 0u;
    __syncthreads();
    const XcdBarrier xbar = xcd_barrier_post(ctl + 1024, misc + 8);

    {
        LAS float* scr = (LAS float*)(lds + wid * 16384);
        for (int f = 0; f < 4; ++f) {
            const int l = f >> 1, which = f & 1;
            convert_matrix((which ? a.in[6] : a.in[3]) + (size_t)l * DM * 2 * DFF, DM, 2 * DFF, (bf16_t*)(a.ws + WS_FFN_IN + f * FFN_IN_BYTES), nullptr, 1, scr, gw, NGW, lane);
            convert_matrix((which ? a.in[7] : a.in[4]) + (size_t)l * DFF * DM, DFF, DM, (bf16_t*)(a.ws + WS_FFN_OUT + f * FFN_OUT_BYTES), nullptr, 0, scr, gw, NGW, lane);
        }
        convert_matrix(a.in[9], DM, EVN_REAL, W_EV_IN, nullptr, 0, scr, gw, NGW, lane);
        convert_matrix(a.in[14], 512, 768, W_UQ, nullptr, 0, scr, gw, NGW, lane);
        convert_matrix(a.in[16], 256, 1024, W_UK, W_UV, 2, scr, gw, NGW, lane);
        convert_matrix(a.in[19], DM, DM, W_EV_OUT, nullptr, 0, scr, gw, NGW, lane);
        convert_matrix(a.in[21], DM, ODN, W_OD_IN, nullptr, 0, scr, gw, NGW, lane);
        convert_matrix(a.in[28], DM, DM, W_OD_OUT, nullptr, 0, scr, gw, NGW, lane);
        { const int gt = blockIdx.x * 512 + tid, NT = G * 512; const u32x4 z4 = (u32x4){0u, 0u, 0u, 0u};
          u32x4* p1 = (u32x4*)(W_EV_IN + (size_t)EVN_REAL * 1024); for (int i = gt; i < (EVN - EVN_REAL) * 1024 / 8; i += NT) p1[i] = z4;
          u32x4* p2 = (u32x4*)(W_OD_IN + (size_t)ODN * 1024); for (int i = gt; i < (ODN_PAD - ODN) * 1024 / 8; i += NT) p2[i] = z4;
          for (int e = gt; e < 8192 * 32; e += NT) { const int p = e >> 5, i = e & 31; const float ang = (float)p * INV32[i]; const double rev = (double)ang * 0.15915494309189535; const float fr = (float)(rev - __builtin_rint(rev));
              T32C[e] = __builtin_amdgcn_cosf(fr); T32S[e] = __builtin_amdgcn_sinf(fr); }
          for (int e = gt; e < 8192 * 16; e += NT) { const int p = e >> 4, i = e & 15; const float ang = (float)p * INV16[i]; const double rev = (double)ang * 0.15915494309189535; const float fr = (float)(rev - __builtin_rint(rev));
              T16C[e] = __builtin_amdgcn_cosf(fr); T16S[e] = __builtin_amdgcn_sinf(fr); } }
    }
    rownorm_rows(a.in[0], a.in[2], XN, gw, NGW, lane);
    grid.sync();

    for (int p = 0; p < 56; ++p) {
        const int st = p % 14, l = (p / 14) & 1, g = p / 28;
        const bool even = (l == 0);
        if ((!even && (st == 6 || st == 7)) || st == 9 || st == 3 || st == 11 || (st == 0 && (l == 1 || g == 0))) continue;
        const int S = g ? 4096 : 8192, nqb = S / 256;
        int tidp = threadIdx.x; asm volatile("" : "+v"(tidp));
        const int tid = tidp, lane = tid & 63, wid = __builtin_amdgcn_readfirstlane(tid >> 6), gw = blockIdx.x * 8 + wid;
        float* xo = a.out + (size_t)g * MG * DM;
        switch (st) {
        case 0: case 3: case 11: {
            const float* xsrc = (l == 0 && st == 0) ? (g ? a.in[1] : a.in[0]) : xo;
            const float* gn = (st == 0) ? a.in[2] + l * DM : (st == 11) ? a.in[5] + l * DM : (even ? a.in[8] : a.in[20]);
            rownorm_rows(xsrc, gn, XN, gw, NGW, lane);
        } break;
        case 1: case 12: {
            const int f = (st == 12);
            pg8::Gemm gm{XN, (const bf16_t*)(a.ws + WS_FFN_IN + (size_t)(l * 2 + f) * FFN_IN_BYTES), MG, 2 * DFF, DM, DM, DM}; pg8::StaticOrder So; So.init(MG, 2 * DFF, G, (int)blockIdx.x);
            pg8::EpiSwiglu E{HB, DFF}; pg8::gemm_phase<pg8::EpiSwiglu, pg8::StaticOrder, true, true>(lds, gm, So, E);
        } break;
        case 2: case 13: {
            const int f = (st == 13);
            const float* xsrc = (l == 0 && f == 0) ? (g ? a.in[1] : a.in[0]) : xo;
            const float* gnext = (f == 0) ? (even ? a.in[8] : a.in[20]) : (a.in[2] + DM);
            pg8::Gemm gm{HB, (const bf16_t*)(a.ws + WS_FFN_OUT + (size_t)(l * 2 + f) * FFN_OUT_BYTES), MG, DM, DFF, DFF, DFF}; pg8::StaticOrder So; So.init(MG, DM, G, (int)blockIdx.x);
            pg8::EpiResidNorm E{xsrc, xo, DM, 0.5f, gnext, XN, XBUF, ctl + 8192 + ((g * 2 + l) * 3 + (f ? 2 : 0)) * 1024}; pg8::gemm_phase<pg8::EpiResidNorm, pg8::StaticOrder, false, true>(lds, gm, So, E);
        } break;
        case 4: {
            if (even) {
                { pg8::Gemm gm{XN, W_EV_IN, MG, EVN, DM, DM, DM}; pg8::StaticOrder So; So.init(MG, EVN, G, (int)blockIdx.x); pg8::EpiStore E{Z, EVN}; pg8::gemm_phase<pg8::EpiStore, pg8::StaticOrder, true, true>(lds, gm, So, E); }
                { pg8::Gemm gm{W_EV_IN + (size_t)640 * DM, XN, 256, MG, DM, DM, DM}; pg8::StaticOrder So; So.init(256, MG, G, (int)((blockIdx.x + 64) & 255)); pg8::EpiStore E{VTA, MG}; pg8::gemm_phase<pg8::EpiStore, pg8::StaticOrder, true, true>(lds, gm, So, E); }
            } else {
                { pg8::Gemm gm{XN, W_OD_IN, MG, ODN, DM, DM, DM}; pg8::StaticOrder So; So.init(MG, ODN, G, (int)blockIdx.x); pg8::EpiStore E{Z, ODN}; pg8::gemm_phase<pg8::EpiStore, pg8::StaticOrder, true, true>(lds, gm, So, E); }
                { pg8::Gemm gm{W_OD_IN + (size_t)1024 * DM, XN, 512, MG, DM, DM, DM}; pg8::StaticOrder So; So.init(512, MG, G, (int)((blockIdx.x + 192) & 255)); pg8::EpiStore E{VTC, MG}; pg8::gemm_phase<pg8::EpiStore, pg8::StaticOrder, true, true>(lds, gm, So, E); }
                { pg8::Gemm gm{W_OD_IN + (size_t)2176 * DM, XN, 256, MG, DM, DM, DM}; pg8::StaticOrder So; So.init(256, MG, G, (int)((blockIdx.x + 64) & 255)); pg8::EpiStore E{VTD, MG}; pg8::gemm_phase<pg8::EpiStore, pg8::StaticOrder, true, true>(lds, gm, So, E); }
            }
        } break;
        case 5: {
            if (even) {
                const float gq = a.in[10][lane], gk = a.in[11][lane];
                const f32x4 gc0 = *(const f32x4*)(a.in[13] + lane * 8), gc1 = *(const f32x4*)(a.in[13] + lane * 8 + 4), gv0 = *(const f32x4*)(a.in[15] + lane * 4);
                bf16_t nx[10]; u32x4 nq; u32x2 nk;
                { const bf16_t* z0 = Z + (size_t)gw * EVN;
#pragma unroll
                  for (int hh = 0; hh < 10; ++hh) nx[hh] = z0[hh * 64 + lane];
                  nq = *(const u32x4*)(z0 + 768 + lane * 8); nk = *(const u32x2*)(z0 + 1280 + lane * 4); }
                for (int r = gw; r < MG; r += NGW) { bf16_t* zr = Z + (size_t)r * EVN; const int pos = r & (S - 1);
                    float v[10], ss[12];
#pragma unroll
                    for (int hh = 0; hh < 10; ++hh) v[hh] = bf2f(nx[hh]);
                    const u32x4 rq = nq; const u32x2 rk = nk;
                    if (r + NGW < MG) { const bf16_t* z1 = zr + (size_t)NGW * EVN;
#pragma unroll
                        for (int hh = 0; hh < 10; ++hh) nx[hh] = z1[hh * 64 + lane];
                        nq = *(const u32x4*)(z1 + 768 + lane * 8); nk = *(const u32x2*)(z1 + 1280 + lane * 4); }
                    const float c = T32C[pos * 32 + (lane & 31)], sn = T32S[pos * 32 + (lane & 31)];
                    float cq[8], ck[4];
                    cq[0] = __uint_as_float(rq.x << 16); cq[1] = __uint_as_float(rq.x & 0xffff0000u); cq[2] = __uint_as_float(rq.y << 16); cq[3] = __uint_as_float(rq.y & 0xffff0000u);
                    cq[4] = __uint_as_float(rq.z << 16); cq[5] = __uint_as_float(rq.z & 0xffff0000u); cq[6] = __uint_as_float(rq.w << 16); cq[7] = __uint_as_float(rq.w & 0xffff0000u);
                    ck[0] = __uint_as_float(rk.x << 16); ck[1] = __uint_as_float(rk.x & 0xffff0000u); ck[2] = __uint_as_float(rk.y << 16); ck[3] = __uint_as_float(rk.y & 0xffff0000u);
#pragma unroll
                    for (int hh = 0; hh < 10; ++hh) ss[hh] = v[hh] * v[hh];
                    ss[10] = ((cq[0] * cq[0] + cq[1] * cq[1]) + (cq[2] * cq[2] + cq[3] * cq[3])) + ((cq[4] * cq[4] + cq[5] * cq[5]) + (cq[6] * cq[6] + cq[7] * cq[7]));
                    ss[11] = (ck[0] * ck[0] + ck[1] * ck[1]) + (ck[2] * ck[2] + ck[3] * ck[3]);
                    wave_sum_n<12>(ss);
                    float y[10], pr[10];
#pragma unroll
                    for (int hh = 0; hh < 10; ++hh) { y[hh] = v[hh] * (1.0f / sqrtf(ss[hh] * (1.f / 64.f) + EPS)) * (hh < 8 ? gq : gk); pr[hh] = __shfl_xor(y[hh], 32); }
#pragma unroll
                    for (int hh = 0; hh < 10; ++hh) { const float o = (lane < 32) ? (y[hh] * c - pr[hh] * sn) : (pr[hh] * sn + y[hh] * c); zr[hh * 64 + lane] = (bf16_t)f2bf(o * (hh < 8 ? 0.125f * LOG2E : 1.0f)); }
                    { const float rs = 1.0f / sqrtf(ss[10] * (1.f / 512.f) + EPS);
                      u32x4 w; w.x = pk2(cq[0] * rs * gc0.x, cq[1] * rs * gc0.y); w.y = pk2(cq[2] * rs * gc0.z, cq[3] * rs * gc0.w); w.z = pk2(cq[4] * rs * gc1.x, cq[5] * rs * gc1.y); w.w = pk2(cq[6] * rs * gc1.z, cq[7] * rs * gc1.w);
                      *(u32x4*)(zr + 768 + lane * 8) = w; }
                    { const float rs = 1.0f / sqrtf(ss[11] * (1.f / 256.f) + EPS);
                      u32x2 w; w.x = pk2(ck[0] * rs * gv0.x, ck[1] * rs * gv0.y); w.y = pk2(ck[2] * rs * gv0.z, ck[3] * rs * gv0.w);
                      *(u32x2*)(zr + 1280 + lane * 4) = w; } }
            } else {
                const float gcq = a.in[22][lane], gck = a.in[23][lane], gdq = a.in[26][lane], gdk = a.in[27][lane];
                bf16_t nx[26];
                { const bf16_t* z0 = Z + (size_t)gw * ODN;
#pragma unroll
                  for (int hh = 0; hh < 16; ++hh) nx[hh] = z0[hh * 64 + lane];
#pragma unroll
                  for (int hh = 0; hh < 10; ++hh) nx[16 + hh] = z0[1536 + hh * 64 + lane]; }
                for (int r = gw; r < MG; r += NGW) { bf16_t* zr = Z + (size_t)r * ODN; const int pos = r & (S - 1);
                    float v[26], ss[26];
#pragma unroll
                    for (int hh = 0; hh < 26; ++hh) v[hh] = bf2f(nx[hh]);
                    if (r + NGW < MG) { const bf16_t* z1 = zr + (size_t)NGW * ODN;
#pragma unroll
                        for (int hh = 0; hh < 16; ++hh) nx[hh] = z1[hh * 64 + lane];
#pragma unroll
                        for (int hh = 0; hh < 10; ++hh) nx[16 + hh] = z1[1536 + hh * 64 + lane]; }
                    const float c = T32C[pos * 32 + (lane & 31)], sn = T32S[pos * 32 + (lane & 31)];
                    const int pp = (lane < 32) ? (pos >> 6) : (pos & 63); const float c2 = T16C[pp * 16 + (lane & 15)], s2 = T16S[pp * 16 + (lane & 15)];
#pragma unroll
                    for (int hh = 0; hh < 26; ++hh) ss[hh] = v[hh] * v[hh];
                    wave_sum_n<26>(ss);
#pragma unroll
                    for (int hh = 0; hh < 16; ++hh) { const float y = v[hh] * (1.0f / sqrtf(ss[hh] * (1.f / 64.f) + EPS)) * (hh < 8 ? gcq : gck); const float pr = __shfl_xor(y, 32);
                        const float o = (lane < 32) ? (y * c - pr * sn) : (pr * sn + y * c); zr[hh * 64 + lane] = (bf16_t)f2bf(o * (hh < 8 ? 0.125f * LOG2E : 1.0f)); }
#pragma unroll
                    for (int hh = 0; hh < 10; ++hh) { const float y = v[16 + hh] * (1.0f / sqrtf(ss[16 + hh] * (1.f / 64.f) + EPS)) * (hh < 8 ? gdq : gdk); const float pr = __shfl_xor(y, 16);
                        const float o = ((lane & 16) == 0) ? (y * c2 - pr * s2) : (pr * s2 + y * c2); zr[1536 + hh * 64 + lane] = (bf16_t)f2bf(o * (hh < 8 ? 0.125f * LOG2E : 1.0f)); } }
            }
        } break;
        case 6: {
            { pg8::Gemm gm{Z + 768, W_UQ, MG, 768, 512, EVN, 512}; pg8::StaticOrder So; So.init(MG, 768, G, (int)blockIdx.x); pg8::EpiStore E{QB, 768}; pg8::gemm_phase<pg8::EpiStore, pg8::StaticOrder, true, true>(lds, gm, So, E); }
            { pg8::Gemm gm{Z + 1280, W_UK, MG, 512, 256, EVN, 256}; pg8::StaticOrder So; So.init(MG, 512, G, (int)((blockIdx.x + 64) & 255)); pg8::EpiStore E{KNOPE, 512}; pg8::gemm_phase<pg8::EpiStore, pg8::StaticOrder, true, true>(lds, gm, So, E); }
            { pg8::Gemm gm{W_UV, Z + 1280, 512, MG, 256, 256, EVN}; pg8::StaticOrder So; So.init(512, MG, G, (int)((blockIdx.x + 192) & 255)); pg8::EpiStore E{VTB, MG}; pg8::gemm_phase<pg8::EpiStore, pg8::StaticOrder, true, true>(lds, gm, So, E); }
        } break;
        case 7: {
            const float gq1 = a.in[17][lane], gq2 = a.in[17][64 + (lane & 31)], gk1 = a.in[18][lane], gk2 = a.in[18][64 + (lane & 31)]; const float qs = 0.10206207261596577f * LOG2E;
            bf16_t n1[8], n2[8], n3[8], nr;
            { const bf16_t* q0 = QB + (size_t)gw * 768; const bf16_t* k0 = KNOPE + (size_t)gw * 512; nr = Z[(size_t)gw * EVN + 1536 + (lane & 31)];
#pragma unroll
              for (int h = 0; h < 8; ++h) { n1[h] = q0[h * 96 + lane]; n2[h] = q0[h * 96 + 64 + (lane & 31)]; n3[h] = k0[h * 64 + lane]; } }
            for (int r = gw; r < MG; r += NGW) { const int pos = r & (S - 1);
                bf16_t* q = QB + (size_t)r * 768; bf16_t* ko = KB + (size_t)r * 768;
                float q1[8], q2[8], k1[8], ss[16];
                const float kr = (lane < 32) ? bf2f(nr) : 0.f;
#pragma unroll
                for (int h = 0; h < 8; ++h) { q1[h] = bf2f(n1[h]); q2[h] = (lane < 32) ? bf2f(n2[h]) : 0.f; k1[h] = bf2f(n3[h]); }
                if (r + NGW < MG) { const bf16_t* q0 = q + (size_t)NGW * 768; const bf16_t* k0 = KNOPE + (size_t)(r + NGW) * 512; nr = Z[(size_t)(r + NGW) * EVN + 1536 + (lane & 31)];
#pragma unroll
                    for (int h = 0; h < 8; ++h) { n1[h] = q0[h * 96 + lane]; n2[h] = q0[h * 96 + 64 + (lane & 31)]; n3[h] = k0[h * 64 + lane]; } }
                const float c = T16C[pos * 16 + (lane & 15)], sn = T16S[pos * 16 + (lane & 15)];
#pragma unroll
                for (int h = 0; h < 8; ++h) { ss[h] = q1[h] * q1[h] + q2[h] * q2[h]; ss[8 + h] = k1[h] * k1[h] + kr * kr; }
                wave_sum_n<16>(ss);
#pragma unroll
                for (int h = 0; h < 8; ++h) {
                    { const float rs = 1.0f / sqrtf(ss[h] * (1.f / 96.f) + EPS); const float y1 = q1[h] * rs * gq1, y2 = q2[h] * rs * gq2; const float pr = __shfl_xor(y2, 16);
                      const float o2 = ((lane & 16) == 0) ? (y2 * c - pr * sn) : (pr * sn + y2 * c);
                      q[h * 96 + lane] = (bf16_t)f2bf(y1 * qs); if (lane < 32) q[h * 96 + 64 + lane] = (bf16_t)f2bf(o2 * qs); }
                    { const float rs = 1.0f / sqrtf(ss[8 + h] * (1.f / 96.f) + EPS); const float y1 = k1[h] * rs * gk1, y2 = kr * rs * gk2; const float pr = __shfl_xor(y2, 16);
                      const float o2 = ((lane & 16) == 0) ? (y2 * c - pr * sn) : (pr * sn + y2 * c);
                      ko[h * 96 + lane] = (bf16_t)f2bf(y1); if (lane < 32) ko[h * 96 + 64 + lane] = (bf16_t)f2bf(o2); } } }
        } break;
        case 8: {
#ifndef ATT_REP
#define ATT_REP 1
#endif
                    for (int rep = 0; rep < ATT_REP; ++rep) {
                    unsigned* qctr = ctl + 64 * (g * 2 + l + 4 * rep);
                    float sb_mla = 0.f, sb_a = 0.f, sb_c = 0.f, sb_d = 0.f;
                    if (even) { sb_a = 1.02f * 8.0f * LOG2E * wave_max(fabsf(a.in[10][lane])) * wave_max(fabsf(a.in[11][lane]));
                                sb_mla = 1.02f * 9.797958971f * LOG2E * wave_max(fmaxf(fabsf(a.in[17][lane]), fabsf(a.in[17][64 + (lane & 31)]))) * wave_max(fmaxf(fabsf(a.in[18][lane]), fabsf(a.in[18][64 + (lane & 31)]))); }
                    else { sb_c = 1.02f * 8.0f * LOG2E * wave_max(fabsf(a.in[22][lane])) * wave_max(fabsf(a.in[23][lane]));
                           sb_d = 1.02f * 8.0f * LOG2E * wave_max(fabsf(a.in[26][lane])) * wave_max(fabsf(a.in[27][lane])); }
                    const int ntot = even ? 1024 : 768;
                    for (;;) {
                        __syncthreads();
                        if (tid == 0) misc[0] = atomicAdd(qctr, 1u);
                        __syncthreads();
                        const int u = (int)misc[0];
                        if (u >= ntot) break;
                        const int r32 = lane & 31, hi = lane >> 5;
                        const int nqb2 = S / 512;
                        if (even) {
                            if (u < 512) {
                                const int qb = u % nqb, h = (u / nqb) & 7, seq = u / (nqb * 8); const int q0 = seq * S + qb * 256, qtok = q0 + wid * 32 + r32;
                                f32x16 o[1][2]; float m[1], lp[1];
                                if (sb_mla < 48.f) attn_core<96, 64, false, 1, true, true>(lds, QB + (size_t)qtok * 768 + h * 96, 768, KB + h * 96, 768, VTB + (size_t)(h * 64) * MG, MG, seq * S, seq * S + S, qtok, o, m, lp, sb_mla);
                                else attn_core<96, 64, false, 1, true, false>(lds, QB + (size_t)qtok * 768 + h * 96, 768, KB + h * 96, 768, VTB + (size_t)(h * 64) * MG, MG, seq * S, seq * S + S, qtok, o, m, lp);
                                store_o<64>(o[0], 1.0f / swap32_sum(lp[0]), XN + (size_t)qtok * DM + 512 + h * 64, hi);
                            } else {
                                const int v = u - 512; const int qb = v % nqb, h = (v / nqb) & 7, seq = v / (nqb * 8); const int q0 = seq * S + qb * 256, qtok = q0 + wid * 32 + r32;
                                const int kbeg = (qb == 0) ? q0 : q0 - 128, kend = (qb == nqb - 1) ? q0 + 256 : q0 + 384;
                                f32x16 o[1][2]; float m[1], lp[1];
                                attn_core<64, 64, true, 1, false, false>(lds, Z + (size_t)qtok * EVN + h * 64, EVN, Z + 512 + (h >> 2) * 64, EVN, VTA + (size_t)((h >> 2) * 64) * MG, MG, kbeg, kend, qtok, o, m, lp, sb_a);
                                const float lt = swap32_sum(lp[0]) + __builtin_amdgcn_exp2f(a.in[12][h] * LOG2E - m[0]);
                                store_o<64>(o[0], 1.0f / lt, XN + (size_t)qtok * DM + h * 64, hi);
                            }
                        } else {
                            if (u >= 256) {
                                const int v = u - 256; const int qb = v % nqb, h = (v / nqb) & 7, seq = v / (nqb * 8); const int q0 = seq * S + qb * 256, qtok = q0 + wid * 32 + r32;
                                f32x16 o[1][2]; float m[1], lp[1];
                                if (sb_d < 48.f) attn_core<64, 64, false, 1, true, true>(lds, Z + (size_t)qtok * ODN + 1536 + h * 64, ODN, Z + 2048 + (h >> 2) * 64, ODN, VTD + (size_t)((h >> 2) * 64) * MG, MG, seq * S, seq * S + S, qtok, o, m, lp, sb_d);
                                else attn_core<64, 64, false, 1, true, false>(lds, Z + (size_t)qtok * ODN + 1536 + h * 64, ODN, Z + 2048 + (h >> 2) * 64, ODN, VTD + (size_t)((h >> 2) * 64) * MG, MG, seq * S, seq * S + S, qtok, o, m, lp);
                                store_o<64>(o[0], 1.0f / swap32_sum(lp[0]), XN + (size_t)qtok * DM + 512 + h * 64, hi);
                            } else {
                                const int qb = u % nqb, h = (u / nqb) & 3, seq = u / (nqb * 4); const int q0 = seq * S + qb * 256, qtok = q0 + wid * 32 + r32;
#pragma unroll 1
                                for (int c = 0; c < 2; ++c) {
                                    f32x16 o[1][4]; float m[1], lp[1];
                                    attn_core<64, 128, false, 1, true, false>(lds, Z + (size_t)qtok * ODN + (2 * h + c) * 64, ODN, Z + 512 + (2 * h + c) * 64, ODN, VTC + (size_t)(h * 128) * MG, MG, seq * S, seq * S + S, qtok, o, m, lp, sb_c);
                                    int tl = threadIdx.x; asm volatile("" : "+v"(tl)); float* stash = O1 + ((size_t)blockIdx.x * 8 + (tl >> 6)) * 4096 + (tl & 63);
                                    if (c == 0) { const float inv = 1.0f / swap32_sum(lp[0]);
#pragma unroll
                                        for (int db = 0; db < 4; ++db)
#pragma unroll
                                            for (int r = 0; r < 16; ++r) stash[(db * 16 + r) * 64] = o[0][db][r] * inv;
                                        asm volatile("s_waitcnt vmcnt(0)" ::: "memory");
                                    } else {
                                        const float* lpm = a.in[24];
                                        const float lam = __expf(wave_sum(lpm[tl & 63] * lpm[64 + (tl & 63)])) - __expf(wave_sum(lpm[128 + (tl & 63)] * lpm[192 + (tl & 63)])) + LAM_INIT;
                                        const float inv2 = lam / swap32_sum(lp[0]); float ss = 0.f;
#pragma unroll
                                        for (int db = 0; db < 4; ++db) {
#pragma unroll
                                            for (int r = 0; r < 16; ++r) { const float d = stash[(db * 16 + r) * 64] - o[0][db][r] * inv2; o[0][db][r] = d; ss += d * d; }
                                            asm volatile("" ::: "memory"); }
                                        const float rs = (1.0f - LAM_INIT) / sqrtf(swap32_sum(ss) * (1.f / 128.f) + EPS);
                                        const float* gon = a.in[25];
                                        bf16_t* dsto = XN + (size_t)qtok * DM + h * 128;
#pragma unroll
                                        for (int db = 0; db < 4; ++db) {
#pragma unroll
                                            for (int rq = 0; rq < 4; ++rq) { const f32x4 g4 = *(const f32x4*)(gon + 32 * db + 8 * rq + 4 * hi);
                                                u32x2 w; w.x = cvtpk(o[0][db][4 * rq] * rs * g4.x, o[0][db][4 * rq + 1] * rs * g4.y); w.y = cvtpk(o[0][db][4 * rq + 2] * rs * g4.z, o[0][db][4 * rq + 3] * rs * g4.w);
                                                *(u32x2*)(dsto + 32 * db + 8 * rq + 4 * hi) = w; }
                                            asm volatile("" ::: "memory"); }
                                    }
                                }
                            }
                        }
                    }
                    }
        } break;
        case 9: {
            const float* lpm = a.in[24]; const float* gon = a.in[25];
            const float lam = __expf(wave_sum(lpm[lane] * lpm[64 + lane])) - __expf(wave_sum(lpm[128 + lane] * lpm[192 + lane])) + LAM_INIT;
            for (int r = gw; r < MG; r += NGW) {
#pragma unroll
                for (int h = 0; h < 4; ++h) { const float* p1 = O1 + ((size_t)r * 8 + 2 * h) * 128 + 2 * lane; const float d0 = p1[0] - lam * p1[128], d1 = p1[1] - lam * p1[129];
                    const float rs = (1.0f - LAM_INIT) / sqrtf(wave_sum(d0 * d0 + d1 * d1) * (1.f / 128.f) + EPS);
                    *(unsigned*)(XN + (size_t)r * DM + h * 128 + 2 * lane) = pk2(d0 * rs * gon[2 * lane], d1 * rs * gon[2 * lane + 1]); } }
        } break;
        case 10: {
            pg8::Gemm gm{XN, even ? W_EV_OUT : W_OD_OUT, MG, DM, DM, DM, DM}; pg8::StaticOrder So; So.init(MG, DM, G, (int)blockIdx.x);
            pg8::EpiResidNorm E{xo, xo, DM, 1.0f, a.in[5] + l * DM, XN, XBUF, ctl + 8192 + ((g * 2 + l) * 3 + 1) * 1024}; pg8::gemm_phase<pg8::EpiResidNorm, pg8::StaticOrder, false, true>(lds, gm, So, E);
        } break;
        }
#ifndef SYNC_REP
#define SYNC_REP 1
#endif
        for (int rep = 0; rep < SYNC_REP; ++rep) xcd_barrier(xbar);
    }
}

extern "C" void kernel_launch(void* const* d_in, const int* in_sizes, int n_in, void* d_out, int out_size, void* d_ws, size_t ws_size, hipStream_t stream) {
    static int grid = 0;
    if (grid == 0) {
        if (n_in != 29 || ws_size < WS_END) { fprintf(stderr, "kernel_launch: unexpected inputs (n_in %d, ws %zu)\n", n_in, ws_size); grid = -1; return; }
        int dev = 0, cus = 0, per_cu = 0;
        hipGetDevice(&dev); hipDeviceGetAttribute(&cus, hipDeviceAttributeMultiprocessorCount, dev);
        hipFuncSetAttribute((const void*)hybrid_fwd, hipFuncAttributeMaxDynamicSharedMemorySize, LDS_BYTES);
        hipOccupancyMaxActiveBlocksPerMultiprocessor(&per_cu, (const void*)hybrid_fwd, 512, LDS_BYTES);
        if (per_cu < 1) per_cu = 1;
        grid = cus * (per_cu > 1 ? 1 : per_cu);
        if (grid != 256) { fprintf(stderr, "kernel_launch: this kernel needs exactly 256 workgroups (one per CU); got %d\n", grid); grid = -1; return; }
        (void)hipGetLastError();
    }
    if (grid < 0) return;
    hipMemsetAsync((char*)d_ws + WS_CTL, 0, 131072, stream);
    Args a{};
    for (int i = 0; i < 29; ++i) a.in[i] = (const float*)d_in[i];
    a.out = (float*)d_out; a.ws = (unsigned char*)d_ws;
    for (int i = 0; i < 32; ++i) INV32[i] = powf(10000.0f, -((float)(2 * i) / 64.0f));
    for (int i = 0; i < 16; ++i) INV16[i] = powf(10000.0f, -((float)(2 * i) / 32.0f));
    void* args[] = {&a};
    hipError_t e = hipLaunchCooperativeKernel((const void*)hybrid_fwd, dim3(grid), dim3(512), args, LDS_BYTES, stream);
    if (e != hipSuccess) fprintf(stderr, "cooperative launch failed: %s (grid %d)\n", hipGetErrorString(e), grid);
}
```

```cpp
#include <hip/hip_runtime.h>
#include <hip/hip_cooperative_groups.h>
#include <cstdio>
#include <cstdint>
#include <cmath>
namespace cg = cooperative_groups;
namespace pg8 {
#define PG8_LAS __attribute__((address_space(3)))
typedef unsigned short bf16_t;
typedef short bf16x8 __attribute__((ext_vector_type(8)));
typedef float f32x4 __attribute__((ext_vector_type(4)));
typedef unsigned u32x4 __attribute__((ext_vector_type(4)));
constexpr int BM = 256, BK = 64, HALF = 128, HTB = HALF * BK * 2  , STAGE_BYTES = 8 * HTB, NXCD = 8, WGM = 8;

__host__ __device__ __forceinline__ int lds_byte(int r, int c) { const int st = (r >> 4) * 2 + (c >> 5), rr = r & 15, cc = c & 31, ob = rr * 64 + cc * 2; return st * 1024 + (ob ^ (((ob >> 9) & 1) << 5)); }
__host__ __device__ __forceinline__ void stage_rc(int b, int& R, int& C) { const int st = b / 1024, sb = b % 1024, swz = sb ^ (((sb >> 9) & 1) << 5); R = (st >> 1) * 16 + swz / 64; C = (st & 1) * 32 + (swz % 64) / 2; }
__host__ __device__ __forceinline__ int perm32(int rho) { const int n = rho >> 4, i = rho & 15; return 8 * (i >> 2) + 4 * n + (i & 3); }

struct Unit { int pm, pn; };
struct Gemm { const bf16_t* A; const bf16_t* Bt; int M, N, K, lda, ldb; };

struct StaticOrder {
    int nM, nN, nwg, G, c;
    __host__ __device__ void init(int M, int N, int G_, int c_) { nM = M / BM; nN = N / BM; nwg = nM * nN; G = G_; c = c_; }
    __host__ __device__ bool next(int i, Unit& u) const {
        const long L = (long)i * G + c; if (L >= nwg) return false;
        int wgid = (int)L; { const int q = nwg / NXCD, r = nwg % NXCD, xcd = wgid % NXCD, off = wgid / NXCD; wgid = (xcd < r ? xcd * (q + 1) : r * (q + 1) + (xcd - r) * q) + off; }
        const int nig = WGM * nN, gid = wgid / nig, fm = gid * WGM, gsz = (nM - fm) < WGM ? (nM - fm) : WGM;
        u.pm = fm + ((wgid % nig) % gsz); u.pn = (wgid % nig) / gsz; return true;
    }
    __device__ __forceinline__ void a_ready(const Unit&) const {}
    __device__ __forceinline__ void done(const Unit&) const {}
};


__device__ __forceinline__ unsigned cvt_pk_bf16(float lo, float hi) { unsigned r; asm volatile("v_cvt_pk_bf16_f32 %0, %1, %2" : "=v"(r) : "v"(lo), "v"(hi)); return r; }

struct EpiStore {
    static constexpr bool PERM = true, AFTER_DRAIN = false;
    bf16_t* O; int ldc;
    __device__ __forceinline__ void operator()(const f32x4 (&acc)[2][2][4][2], const Unit& u, int wr, int wc, int fr, int fq) const {
        const int row0 = u.pm * BM + wr * 64 + fr; const int col0 = u.pn * BM + wc * 32 + 8 * fq;
#pragma unroll
        for (int ai = 0; ai < 2; ++ai)
#pragma unroll
            for (int m = 0; m < 4; ++m) { bf16_t* rowp = O + (size_t)(row0 + ai * HALF + m * 16) * ldc + col0;
#pragma unroll
                for (int bj = 0; bj < 2; ++bj) { const f32x4 v0 = acc[ai][bj][m][0], v1 = acc[ai][bj][m][1];
                    u32x4 w; w.x = cvt_pk_bf16(v0[0], v0[1]); w.y = cvt_pk_bf16(v0[2], v0[3]); w.z = cvt_pk_bf16(v1[0], v1[1]); w.w = cvt_pk_bf16(v1[2], v1[3]);
                    *(u32x4*)(rowp + bj * HALF) = w; } }
    }
};
__device__ __forceinline__ float silu_mul(float g, float u) { const float e = __builtin_amdgcn_exp2f(g * -1.4426950408889634f); return g * __builtin_amdgcn_rcpf(1.0f + e) * u; }
struct EpiSwiglu {
    static constexpr bool PERM = true, AFTER_DRAIN = false;
    bf16_t* H; int ldh;
    __device__ __forceinline__ void operator()(const f32x4 (&acc)[2][2][4][2], const Unit& u, int wr, int wc, int fr, int fq) const {
        const int row0 = u.pm * BM + wr * 64 + fr; const int col0 = u.pn * HALF + wc * 32 + 8 * fq;
#pragma unroll
        for (int ai = 0; ai < 2; ++ai)
#pragma unroll
            for (int m = 0; m < 4; ++m) { bf16_t* rowp = H + (size_t)(row0 + ai * HALF + m * 16) * ldh + col0;
                const f32x4 g0 = acc[ai][0][m][0], g1 = acc[ai][0][m][1], u0 = acc[ai][1][m][0], u1 = acc[ai][1][m][1];
                u32x4 w; w.x = cvt_pk_bf16(silu_mul(g0[0], u0[0]), silu_mul(g0[1], u0[1])); w.y = cvt_pk_bf16(silu_mul(g0[2], u0[2]), silu_mul(g0[3], u0[3]));
                w.z = cvt_pk_bf16(silu_mul(g1[0], u1[0]), silu_mul(g1[1], u1[1])); w.w = cvt_pk_bf16(silu_mul(g1[2], u1[2]), silu_mul(g1[3], u1[3]));
                *(u32x4*)rowp = w; }
    }
};
struct EpiResid {
    static constexpr bool PERM = false, AFTER_DRAIN = false;
    const float* base; float* out; int ldc; float scale;
    __device__ __forceinline__ void operator()(const f32x4 (&acc)[2][2][4][2], const Unit& u, int wr, int wc, int fr, int fq) const {
        const int row0 = u.pm * BM + wr * 64 + fr; const int col0 = u.pn * BM + wc * 32 + 4 * fq;
#pragma unroll
        for (int ai = 0; ai < 2; ++ai)
#pragma unroll
            for (int m = 0; m < 4; ++m) { const size_t off = (size_t)(row0 + ai * HALF + m * 16) * ldc + col0;
#pragma unroll
                for (int bj = 0; bj < 2; ++bj)
#pragma unroll
                    for (int n = 0; n < 2; ++n) { const f32x4 b = *(const f32x4*)(base + off + bj * HALF + n * 16); *(f32x4*)(out + off + bj * HALF + n * 16) = b + acc[ai][bj][m][n] * scale; }
                asm volatile("" ::: "memory"); }
    }
};

struct EpiResidNorm {
    static constexpr bool PERM = false, AFTER_DRAIN = true;
    const float* base; float* out; int ldc; float scale; const float* gain; bf16_t* xn; unsigned* xbuf; unsigned* cnt; int do_norm;
    __device__ __forceinline__ void fused(f32x4 (&acc)[2][2][4][2], const Unit& u, int wr, int wc, int fr, int fq, PG8_LAS unsigned char* lds, int wid, int lane) const {
        PG8_LAS float* P = (PG8_LAS float*)lds;
        PG8_LAS float* S = (PG8_LAS float*)(lds + 4096);
        const int col0 = u.pn * BM + wc * 32 + 4 * fq;
#pragma unroll
        for (int ai = 0; ai < 2; ++ai) {
            f32x4 bv[4][2][2];
#pragma unroll
            for (int m = 0; m < 4; ++m) { const size_t off = (size_t)(u.pm * BM + ai * HALF + wr * 64 + m * 16 + fr) * ldc + col0;
#pragma unroll
                for (int bj = 0; bj < 2; ++bj)
#pragma unroll
                    for (int n = 0; n < 2; ++n) bv[m][bj][n] = *(const f32x4*)(base + off + bj * HALF + n * 16); }
            asm volatile("" ::: "memory");
#pragma unroll
            for (int m = 0; m < 4; ++m) { const size_t off = (size_t)(u.pm * BM + ai * HALF + wr * 64 + m * 16 + fr) * ldc + col0; float sq = 0.f;
#pragma unroll
                for (int bj = 0; bj < 2; ++bj)
#pragma unroll
                    for (int n = 0; n < 2; ++n) { const f32x4 v = bv[m][bj][n] + acc[ai][bj][m][n] * scale; acc[ai][bj][m][n] = v;
                        *(f32x4*)(out + off + bj * HALF + n * 16) = v; sq += (v[0] * v[0] + v[1] * v[1]) + (v[2] * v[2] + v[3] * v[3]); }
                sq += __shfl_xor(sq, 16); sq += __shfl_xor(sq, 32);
                if (fq == 0) P[(ai * HALF + wr * 64 + m * 16 + fr) * 4 + wc] = sq; }
            asm volatile("" ::: "memory"); }
        if (!do_norm) return;
        asm volatile("s_waitcnt lgkmcnt(0)" ::: "memory"); __builtin_amdgcn_s_barrier(); asm volatile("" ::: "memory");
        const int row = wid * 32 + (lane & 31);
        if (lane < 32) { const float t = (P[row * 4 + 0] + P[row * 4 + 1]) + (P[row * 4 + 2] + P[row * 4 + 3]);
            __hip_atomic_store(xbuf + ((size_t)(u.pm * BM + row) * 4 + u.pn), __float_as_uint(t), __ATOMIC_RELAXED, __HIP_MEMORY_SCOPE_AGENT); }
        asm volatile("s_waitcnt vmcnt(0)" ::: "memory");
        if (lane == 0) __hip_atomic_fetch_add(cnt + 16 * u.pm, 1u, __ATOMIC_RELAXED, __HIP_MEMORY_SCOPE_AGENT);
        if (wid == 0) {
            unsigned sp = 0;
            while ((unsigned)__builtin_amdgcn_readfirstlane(__hip_atomic_load(cnt + 16 * u.pm, __ATOMIC_RELAXED, __HIP_MEMORY_SCOPE_AGENT)) < 32u) { __builtin_amdgcn_s_sleep(2); if (++sp > (1u << 22)) break; }
            __builtin_amdgcn_fence(__ATOMIC_ACQUIRE, "agent");
        }
        asm volatile("s_waitcnt vmcnt(0) lgkmcnt(0)" ::: "memory"); __builtin_amdgcn_s_barrier(); asm volatile("" ::: "memory");
        if (lane < 32) { const unsigned* slot = xbuf + (size_t)(u.pm * BM + row) * 4; float ss = 0.f;
#pragma unroll
            for (int t = 0; t < 4; ++t) ss += __uint_as_float(__hip_atomic_load(slot + t, __ATOMIC_RELAXED, __HIP_MEMORY_SCOPE_AGENT));
            S[row] = 1.0f / sqrtf(ss * (1.0f / 1024.0f) + 1e-6f); }
        asm volatile("s_waitcnt lgkmcnt(0)" ::: "memory"); __builtin_amdgcn_s_barrier(); asm volatile("" ::: "memory");
        typedef unsigned u32x2v __attribute__((ext_vector_type(2)));
#pragma unroll
        for (int ai = 0; ai < 2; ++ai)
#pragma unroll
            for (int m = 0; m < 4; ++m) { const int r = ai * HALF + wr * 64 + m * 16 + fr; const float rs = S[r]; const size_t off = (size_t)(u.pm * BM + r) * ldc + col0;
#pragma unroll
                for (int bj = 0; bj < 2; ++bj)
#pragma unroll
                    for (int n = 0; n < 2; ++n) { const f32x4 g4 = *(const f32x4*)(gain + col0 + bj * HALF + n * 16); const f32x4 o = acc[ai][bj][m][n] * rs * g4;
                        u32x2v w; w.x = cvt_pk_bf16(o[0], o[1]); w.y = cvt_pk_bf16(o[2], o[3]); *(u32x2v*)(xn + off + bj * HALF + n * 16) = w; } }
    }
};

template <class Epi, class Sched, bool ALIGN_EPI = false, bool SP2 = false>
__device__ __forceinline__ void gemm_phase(PG8_LAS unsigned char* lds, const Gemm g, const Sched& S, const Epi& E) {
    int tid_ = threadIdx.x; asm volatile("" : "+v"(tid_));
    const int tid = tid_, wid = __builtin_amdgcn_readfirstlane(tid >> 6), lane = tid & 63, wr = wid >> 2, wc = wid & 3, fr = lane & 15, fq = lane >> 4;
    const int K = g.K, nt = K / BK;
    unsigned voffA[2], voffB[2];
#pragma unroll
    for (int i = 0; i < 2; ++i) { int R, C; stage_rc(tid * 16 + i * 8192, R, C); const int Rb = Epi::PERM ? ((R & ~31) + perm32(R & 31)) : R;
        voffA[i] = (unsigned)(R * g.lda + C) * 2u; voffB[i] = (unsigned)(Rb * g.ldb + C) * 2u; }
    const size_t kstep = (size_t)(BK * 2);
    const size_t hstepA = (size_t)HALF * g.lda * 2, hstepB = (size_t)HALF * g.ldb * 2;
    const size_t tstepA = 2 * hstepA, tstepB = 2 * hstepB;
    const unsigned ldsw = (unsigned)wid * 1024u;
    const int aoff = lds_byte(wr * 64 + fr, fq * 8), boff = lds_byte(wc * 32 + fr, fq * 8);
#define PG8_SA(b, h) (((b) * 2 + (h)) * HTB)
#define PG8_SB(b, h) ((4 + (b) * 2 + (h)) * HTB)
#define PG8_STAGE(bufoff, gbase, voff) do { _Pragma("unroll") for (int _i = 0; _i < 2; ++_i) \
        __builtin_amdgcn_global_load_lds((const unsigned*)((const char*)(gbase) + (voff)[_i]), (PG8_LAS unsigned*)(lds + (bufoff) + ldsw + _i * 8192), 16, 0, 0); } while (0)
#define PG8_LDA(dst, b, h) do { _Pragma("unroll") for (int m = 0; m < 4; ++m) _Pragma("unroll") for (int k = 0; k < 2; ++k) dst[m][k] = *(const PG8_LAS bf16x8*)(lds + PG8_SA(b, h) + aoff + m * 2048 + k * 1024); } while (0)
#define PG8_LDB(dst, b, h) do { _Pragma("unroll") for (int n = 0; n < 2; ++n) _Pragma("unroll") for (int k = 0; k < 2; ++k) dst[n][k] = *(const PG8_LAS bf16x8*)(lds + PG8_SB(b, h) + boff + n * 2048 + k * 1024); } while (0)
#define PG8_MMA(ai, bj, At, Bt) do { __builtin_amdgcn_s_setprio(1); _Pragma("unroll") for (int m = 0; m < 4; ++m) _Pragma("unroll") for (int n = 0; n < 2; ++n) _Pragma("unroll") for (int k = 0; k < 2; ++k) \
        acc[ai][bj][m][n] = __builtin_amdgcn_mfma_f32_16x16x32_bf16(Bt[n][k], At[m][k], acc[ai][bj][m][n], 0, 0, 0); __builtin_amdgcn_s_setprio(0); } while (0)
#define PG8_WAIT_V(n) asm volatile("s_waitcnt vmcnt(" #n ")" ::: "memory")
#define PG8_WAIT_L(n) asm volatile("s_waitcnt lgkmcnt(" #n ")" ::: "memory")
#define PG8_BAR __builtin_amdgcn_s_barrier()
#define PG8_SCHED __builtin_amdgcn_sched_barrier(0)
    Unit cur, nxt; int ui = 0;
    if (!S.next(0, cur)) return;
    f32x4 acc[2][2][4][2];
#pragma unroll
    for (int a = 0; a < 2; ++a)
#pragma unroll
        for (int b = 0; b < 2; ++b)
#pragma unroll
            for (int m = 0; m < 4; ++m)
#pragma unroll
                for (int n = 0; n < 2; ++n) acc[a][b][m][n] = (f32x4){0.f, 0.f, 0.f, 0.f};
    bf16x8 At[4][2], B0[2][2], B1[2][2];
    const char* cA = (const char*)g.A + (size_t)cur.pm * tstepA; const char* cB = (const char*)g.Bt + (size_t)cur.pn * tstepB;
    S.a_ready(cur);
    if constexpr (SP2) {
        PG8_STAGE(PG8_SB(0, 0), cB, voffB); PG8_STAGE(PG8_SB(0, 1), cB + hstepB, voffB); PG8_STAGE(PG8_SA(0, 0), cA, voffA); PG8_STAGE(PG8_SA(0, 1), cA + hstepA, voffA);
        if (wr == 1) PG8_BAR;
        PG8_WAIT_V(2); PG8_BAR;
        PG8_STAGE(PG8_SB(1, 0), cB + kstep, voffB); PG8_STAGE(PG8_SA(1, 0), cA + kstep, voffA); PG8_STAGE(PG8_SB(1, 1), cB + hstepB + kstep, voffB);
        PG8_WAIT_V(6); PG8_BAR;
    } else {
        PG8_STAGE(PG8_SB(0, 0), cB, voffB); PG8_STAGE(PG8_SA(0, 0), cA, voffA); PG8_STAGE(PG8_SB(0, 1), cB + hstepB, voffB); PG8_STAGE(PG8_SA(0, 1), cA + hstepA, voffA);
        if (wr == 1) PG8_BAR;
        PG8_WAIT_V(4); PG8_BAR;
        PG8_STAGE(PG8_SB(1, 0), cB + kstep, voffB); PG8_STAGE(PG8_SA(1, 0), cA + kstep, voffA); PG8_STAGE(PG8_SB(1, 1), cB + hstepB + kstep, voffB);
        PG8_WAIT_V(6); PG8_BAR;
    }
    for (;;) {
        const bool has_next = S.next(ui + 1, nxt);
        const char* nA = has_next ? (const char*)g.A + (size_t)nxt.pm * tstepA : cA; const char* nB = has_next ? (const char*)g.Bt + (size_t)nxt.pn * tstepB : cB;
        for (int t = 0; t < nt; t += 2) {
            const bool last = (t == nt - 2);
            const char* a1 = cA + (size_t)(t + 1) * kstep;
            const char* a2 = last ? nA : cA + (size_t)(t + 2) * kstep; const char* b2 = last ? nB : cB + (size_t)(t + 2) * kstep;
            const char* a3 = a2 + kstep; const char* b3 = b2 + kstep;
            if (last && has_next) S.a_ready(nxt);
            if constexpr (SP2) {
            PG8_LDB(B0, 0, 0); PG8_LDB(B1, 0, 1); PG8_SCHED; PG8_LDA(At, 0, 0); PG8_STAGE(PG8_SA(1, 1), a1 + hstepA, voffA);
            PG8_WAIT_V(8); PG8_WAIT_L(0); PG8_BAR; PG8_MMA(0, 0, At, B0); PG8_MMA(0, 1, At, B1); PG8_BAR; PG8_SCHED;
            PG8_LDA(At, 0, 1); PG8_STAGE(PG8_SB(0, 0), b2, voffB); PG8_STAGE(PG8_SB(0, 1), b2 + hstepB, voffB); PG8_STAGE(PG8_SA(0, 0), a2, voffA);
            PG8_WAIT_V(8); PG8_WAIT_L(0); PG8_BAR; PG8_MMA(1, 0, At, B0); PG8_MMA(1, 1, At, B1); PG8_BAR; PG8_SCHED;
            PG8_LDB(B0, 1, 0); PG8_LDB(B1, 1, 1); PG8_SCHED; PG8_LDA(At, 1, 0); PG8_STAGE(PG8_SA(0, 1), a2 + hstepA, voffA);
            PG8_WAIT_V(8); PG8_WAIT_L(0); PG8_BAR; PG8_MMA(0, 0, At, B0); PG8_MMA(0, 1, At, B1); PG8_BAR; PG8_SCHED;
            PG8_LDA(At, 1, 1); PG8_STAGE(PG8_SB(1, 0), b3, voffB); PG8_STAGE(PG8_SB(1, 1), b3 + hstepB, voffB); PG8_STAGE(PG8_SA(1, 0), a3, voffA);
            PG8_WAIT_V(8); PG8_WAIT_L(0); PG8_BAR; PG8_MMA(1, 0, At, B0); PG8_MMA(1, 1, At, B1); PG8_BAR; PG8_SCHED;
            } else {
            PG8_LDB(B0, 0, 0); PG8_SCHED; PG8_LDA(At, 0, 0); PG8_STAGE(PG8_SA(1, 1), a1 + hstepA, voffA);
            PG8_WAIT_L(8); PG8_BAR; PG8_WAIT_L(0); PG8_MMA(0, 0, At, B0); PG8_BAR; PG8_SCHED;
            PG8_LDB(B1, 0, 1); PG8_STAGE(PG8_SB(0, 0), b2, voffB);
            PG8_BAR; PG8_WAIT_L(0); PG8_MMA(0, 1, At, B1); PG8_BAR;
            PG8_LDA(At, 0, 1); PG8_STAGE(PG8_SA(0, 0), a2, voffA);
            PG8_BAR; PG8_WAIT_L(0); PG8_MMA(1, 0, At, B0); PG8_BAR; PG8_SCHED;
            PG8_STAGE(PG8_SB(0, 1), b2 + hstepB, voffB);
            PG8_WAIT_V(6); PG8_BAR; PG8_MMA(1, 1, At, B1); PG8_BAR;
            PG8_LDB(B0, 1, 0); PG8_SCHED; PG8_LDA(At, 1, 0); PG8_STAGE(PG8_SA(0, 1), a2 + hstepA, voffA);
            PG8_WAIT_L(8); PG8_BAR; PG8_WAIT_L(0); PG8_MMA(0, 0, At, B0); PG8_BAR; PG8_SCHED;
            PG8_LDB(B1, 1, 1); PG8_STAGE(PG8_SB(1, 0), b3, voffB);
            PG8_BAR; PG8_WAIT_L(0); PG8_MMA(0, 1, At, B1); PG8_BAR;
            PG8_LDA(At, 1, 1); PG8_STAGE(PG8_SA(1, 0), a3, voffA);
            PG8_BAR; PG8_WAIT_L(0); PG8_MMA(1, 0, At, B0); PG8_BAR; PG8_SCHED;
            PG8_STAGE(PG8_SB(1, 1), b3 + hstepB, voffB);
            PG8_WAIT_V(6); PG8_BAR; PG8_MMA(1, 1, At, B1); PG8_BAR;
            }
        }
        if constexpr (ALIGN_EPI) { if (wr == 0) PG8_BAR; }
        if constexpr (!Epi::AFTER_DRAIN) { E(acc, cur, wr, wc, fr, fq); S.done(cur); }
        if (!has_next) break;
#pragma unroll
        for (int a = 0; a < 2; ++a)
#pragma unroll
            for (int b = 0; b < 2; ++b)
#pragma unroll
                for (int m = 0; m < 4; ++m)
#pragma unroll
                    for (int n = 0; n < 2; ++n) acc[a][b][m][n] = (f32x4){0.f, 0.f, 0.f, 0.f};
        cur = nxt; cA = nA; cB = nB; ++ui;
        if constexpr (ALIGN_EPI) { if (wr == 1) PG8_BAR; }
    }
    PG8_WAIT_V(0);
    if constexpr (!ALIGN_EPI) { if (wr == 0) PG8_BAR; }
    PG8_BAR;
    if constexpr (Epi::AFTER_DRAIN) { E.fused(acc, cur, wr, wc, fr, fq, lds, wid, lane); S.done(cur); }
#undef PG8_SA
#undef PG8_SB
#undef PG8_STAGE
#undef PG8_LDA
#undef PG8_LDB
#undef PG8_MMA
#undef PG8_WAIT_V
#undef PG8_WAIT_L
#undef PG8_BAR
#undef PG8_SCHED
}
}

#define LAS __attribute__((address_space(3)))
typedef unsigned short bf16_t;
typedef short bf16x8 __attribute__((ext_vector_type(8)));
typedef short s16x4 __attribute__((ext_vector_type(4)));
typedef float f32x4 __attribute__((ext_vector_type(4)));
typedef float f32x16 __attribute__((ext_vector_type(16)));
typedef unsigned u32x4 __attribute__((ext_vector_type(4)));
typedef unsigned u32x2 __attribute__((ext_vector_type(2)));

constexpr int DM = 1024, DFF = 2816, MG = 16384;
constexpr int EVN = 1792, EVN_REAL = 1568, ODN = 2304, ODN_PAD = 2432;
constexpr float EPS = 1e-6f, LOG2E = 1.4426950408889634f;
constexpr float LAM_INIT = 0.35550906f;
constexpr size_t MiB = 1u << 20;
constexpr size_t WS_CTL = 0, WS_T32C = 1 * MiB, WS_T32S = 2 * MiB, WS_T16C = 3 * MiB, WS_T16S = 3 * MiB + 512 * 1024;
constexpr size_t WS_FFN_IN = 4 * MiB, FFN_IN_BYTES = 11 * MiB, WS_FFN_OUT = WS_FFN_IN + 4 * FFN_IN_BYTES, FFN_OUT_BYTES = 5 * MiB + 512 * 1024;
constexpr size_t WS_EV_IN = 70 * MiB, WS_UQ = WS_EV_IN + (size_t)EVN * 1024 * 2, WS_UK = WS_UQ + 768 * 512 * 2, WS_UV = WS_UK + 512 * 256 * 2, WS_EV_OUT = WS_UV + 512 * 256 * 2;
constexpr size_t WS_OD_IN = WS_EV_OUT + 2 * MiB, WS_OD_OUT = WS_OD_IN + (size_t)ODN_PAD * 1024 * 2, WS_W_END = WS_OD_OUT + 2 * MiB;
static_assert(WS_W_END <= 84 * MiB, "weights");
constexpr size_t WS_XN = 84 * MiB;
constexpr size_t WS_R = 116 * MiB;
constexpr size_t WS_H = WS_R;
constexpr size_t WS_Z = WS_R;
constexpr size_t WS_VTA = WS_R + 56 * MiB, WS_QB = WS_R + 64 * MiB, WS_KNOPE = WS_R + 88 * MiB, WS_KB = WS_R + 104 * MiB, WS_VTB = WS_R + 128 * MiB;
constexpr size_t WS_VTC = WS_R + 72 * MiB, WS_VTD = WS_R + 88 * MiB, WS_O1 = WS_R + 96 * MiB;
constexpr size_t WS_END = WS_R + 160 * MiB;
constexpr int LDS_BYTES = 147456, MISC_OFF = 131072;

__device__ __forceinline__ float bf2f(bf16_t h) { return __uint_as_float((unsigned)h << 16); }
__device__ __forceinline__ unsigned f2bf(float f) { unsigned u = __float_as_uint(f); return (u + 0x7fffu + ((u >> 16) & 1u)) >> 16; }
__device__ __forceinline__ unsigned pk2(float lo, float hi) { return f2bf(lo) | (f2bf(hi) << 16); }
__device__ __forceinline__ float wave_sum(float v) {
#pragma unroll
    for (int o = 1; o < 64; o <<= 1) v += __shfl_xor(v, o);
    return v;
}
__device__ __forceinline__ float swap32_max(float v) { auto rr = __builtin_amdgcn_permlane32_swap(__float_as_uint(v), __float_as_uint(v), false, false); return fmaxf(__uint_as_float(rr[0]), __uint_as_float(rr[1])); }
__device__ __forceinline__ float swap32_sum(float v) { auto rr = __builtin_amdgcn_permlane32_swap(__float_as_uint(v), __float_as_uint(v), false, false); return __uint_as_float(rr[0]) + __uint_as_float(rr[1]); }
__device__ __forceinline__ unsigned cvtpk(float lo, float hi) { typedef float f2 __attribute__((ext_vector_type(2))); typedef __bf16 b2 __attribute__((ext_vector_type(2))); f2 v = {lo, hi}; b2 b = __builtin_convertvector(v, b2); return __builtin_bit_cast(unsigned, b); }

#define XB_TMO      128
#define XB_XCNT(j)  (256  + 64 * (j))
#define XB_XSUB(j)  (1280 + 64 * (j))
#define XB_XGEN(j)  (2304 + 64 * (j))
#define XB_TOP      3328
#define XB_TOPGEN   3392
#define XCD_BAR_WORDS 3456
#define XB_SPIN_CAP (1u << 18)

__device__ __forceinline__ unsigned xb_ld(unsigned* p)              { return __hip_atomic_load(p, __ATOMIC_RELAXED, __HIP_MEMORY_SCOPE_AGENT); }
__device__ __forceinline__ unsigned xb_add(unsigned* p, unsigned v) { return __hip_atomic_fetch_add(p, v, __ATOMIC_RELAXED, __HIP_MEMORY_SCOPE_AGENT); }
__device__ __forceinline__ unsigned xb_xcc_id() { return (unsigned)__builtin_amdgcn_s_getreg((3 << 11) | 20) & 0xFu; }
#define XB_SPIN(cond, bar) do { unsigned _sp = 0; while (cond) { __builtin_amdgcn_s_sleep(1); \
    if ((++_sp & 255u) == 0u) { if (xb_ld(&(bar)[XB_TMO])) break; if (_sp > XB_SPIN_CAP) { atomicAdd(&(bar)[XB_TMO], 1u); break; } } } } while (0)

struct XcdBarrier {
    unsigned* bar; unsigned x;
    volatile LAS unsigned* st;
};

__device__ __forceinline__ XcdBarrier xcd_barrier_post(unsigned* bar, volatile LAS unsigned* st) {
    XcdBarrier b; b.bar = bar; b.x = xb_xcc_id(); b.st = st;
    if (threadIdx.x == 0) (void)xb_add(&bar[XB_XCNT(b.x)], 1u);
    return b;
}
__device__ __forceinline__ void xcd_barrier_complete(unsigned* bar, unsigned x, unsigned& nloc, unsigned& nx) {
    const unsigned G = gridDim.x * gridDim.y * gridDim.z;
    unsigned sum, cnt, mine, sp = 0u;
    for (;;) {
        sum = 0u; cnt = 0u; mine = 0u;
#pragma unroll
        for (unsigned j = 0; j < 16; ++j) { const unsigned c = xb_ld(&bar[XB_XCNT(j)]); sum += c; cnt += (c > 0u) ? 1u : 0u; mine = (j == x) ? c : mine; }
        if (sum == G) break;
        __builtin_amdgcn_s_sleep(1);
        if ((++sp & 255u) == 0u) { if (xb_ld(&bar[XB_TMO])) break; if (sp > XB_SPIN_CAP) { atomicAdd(&bar[XB_TMO], 1u); break; } }
    }
    nloc = mine > 0u ? mine : 1u; nx = cnt > 0u ? cnt : 1u;
}

__device__ __forceinline__ void xcd_barrier(const XcdBarrier& b) {
    asm volatile("s_waitcnt vmcnt(0)" ::: "memory");
    __syncthreads();
    if (threadIdx.x == 0) {
        unsigned* bar = b.bar;
        __builtin_amdgcn_s_waitcnt(0);
        unsigned nloc = b.st[0], nx = b.st[1];
        if (nloc == 0u) { xcd_barrier_complete(bar, b.x, nloc, nx); b.st[0] = nloc; b.st[1] = nx; }
        const unsigned old = xb_add(&bar[XB_XSUB(b.x)], 1u);
        const unsigned gen = old / nloc;
        if (old + 1u == (gen + 1u) * nloc) {
            __builtin_amdgcn_fence(__ATOMIC_RELEASE, "agent");
            asm volatile("s_waitcnt vmcnt(0)" ::: "memory");
            const unsigned og = xb_add(&bar[XB_TOP], 1u);
            const unsigned tg = og / nx;
            if (og + 1u == (tg + 1u) * nx) xb_add(&bar[XB_TOPGEN], 1u);
            else XB_SPIN(xb_ld(&bar[XB_TOPGEN]) == tg, bar);
            __builtin_amdgcn_fence(__ATOMIC_ACQUIRE, "agent");
            xb_add(&bar[XB_XGEN(b.x)], 1u);
            asm volatile("s_waitcnt vmcnt(0)" ::: "memory");
        } else {
            XB_SPIN(xb_ld(&bar[XB_XGEN(b.x)]) == gen, bar);
            __builtin_amdgcn_fence(__ATOMIC_ACQUIRE, "agent");
            asm volatile("s_waitcnt vmcnt(0)" ::: "memory");
        }
    }
    __syncthreads();
}

__device__ __forceinline__ float max3f(float a, float b, float c) { float r; asm("v_max3_f32 %0, %1, %2, %3" : "=v"(r) : "v"(a), "v"(b), "v"(c)); return r; }
typedef float f32x2 __attribute__((ext_vector_type(2)));
template <int DQK, int DV, bool WIN, int NQ, bool DEEP = false, bool FIXM = false>
__device__ __forceinline__ void attn_core(LAS unsigned char* lds, const bf16_t* qrowp, int ldq, const bf16_t* Kp, int ldk, const bf16_t* Vtp, int ldv, int kbeg, int kend, int qtok,
                                          f32x16 (&o)[NQ][DV / 32], float (&m_out)[NQ], float (&l_out)[NQ], float sbound = 0.f) {
    constexpr int KROW = DQK * 2 + 16, KT = 64 * KROW, VROW = 144, VT = DV * VROW, BUF = KT + VT;
    constexpr int KCH = DQK / 8, NKC = 64 * KCH, NKL = (NKC + 511) / 512, NVL = DV / 64;
    constexpr float THR = 8.0f;
    int tid_ = threadIdx.x; asm volatile("" : "+v"(tid_));
    const int tid = tid_, lane = tid & 63, r32 = lane & 31, hi = lane >> 5;
    const int wq0 = __builtin_amdgcn_readfirstlane(qtok - r32);
    bf16x8 qf[NQ][DQK / 16];
#pragma unroll
    for (int g = 0; g < NQ; ++g)
#pragma unroll
        for (int s = 0; s < DQK / 16; ++s) qf[g][s] = *(const bf16x8*)(qrowp + (size_t)(32 * g) * ldq + 16 * s + 8 * hi);
    float m[NQ], l[NQ];
#pragma unroll
    for (int g = 0; g < NQ; ++g) { m[g] = FIXM ? sbound : -1e30f; l[g] = 0.f;
#pragma unroll
        for (int db = 0; db < DV / 32; ++db)
#pragma unroll
            for (int r = 0; r < 16; ++r) o[g][db][r] = 0.f; }
    u32x4 kst[2][NKL], vst[2][NVL];
    const int nt = (kend - kbeg) >> 6;
#define AT_GLOAD(set, t) do { const int key0_ = kbeg + 64 * (t); \
        _Pragma("unroll") for (int i_ = 0; i_ < NKL; ++i_) { const int c_ = tid + 512 * i_; if ((NKC % 512 == 0) || c_ < NKC) { const int row_ = c_ / KCH, cc_ = c_ % KCH; kst[set][i_] = *(const u32x4*)(Kp + (size_t)(key0_ + row_) * ldk + cc_ * 8); } } \
        _Pragma("unroll") for (int i_ = 0; i_ < NVL; ++i_) { const int c_ = tid + 512 * i_; const int d_ = c_ >> 3, cc_ = c_ & 7; vst[set][i_] = *(const u32x4*)(Vtp + (size_t)d_ * ldv + key0_ + cc_ * 8); } } while (0)
#define AT_LSTORE(set, buf) do { LAS unsigned char* B_ = lds + (buf) * BUF; \
        _Pragma("unroll") for (int i_ = 0; i_ < NKL; ++i_) { const int c_ = tid + 512 * i_; if ((NKC % 512 == 0) || c_ < NKC) { const int row_ = c_ / KCH, cc_ = c_ % KCH; *(LAS u32x4*)(B_ + row_ * KROW + cc_ * 16) = kst[set][i_]; } } \
        _Pragma("unroll") for (int i_ = 0; i_ < NVL; ++i_) { const int c_ = tid + 512 * i_; const int d_ = c_ >> 3, cc_ = c_ & 7; LAS unsigned char* p_ = B_ + KT + d_ * VROW + (cc_ >> 1) * 32 + (cc_ & 1) * 8; \
            *(LAS u32x2*)p_ = (u32x2){vst[set][i_].x, vst[set][i_].y}; *(LAS u32x2*)(p_ + 16) = (u32x2){vst[set][i_].z, vst[set][i_].w}; } } while (0)
    constexpr int NLD = NKL + NVL;
#define AT_GLOAD_ASM(set, t) do { const int key0_ = kbeg + 64 * (t); \
        _Pragma("unroll") for (int i_ = 0; i_ < NKL; ++i_) { int c_ = tid + 512 * i_; if (c_ > NKC - 1) c_ = NKC - 1; const int row_ = c_ / KCH, cc_ = c_ % KCH; const bf16_t* gp_ = Kp + (size_t)(key0_ + row_) * ldk + cc_ * 8; \
            asm volatile("global_load_dwordx4 %0, %1, off" : "=&v"(kst[set][i_]) : "v"(gp_)); } \
        _Pragma("unroll") for (int i_ = 0; i_ < NVL; ++i_) { const int c_ = tid + 512 * i_; const int d_ = c_ >> 3, cc_ = c_ & 7; const bf16_t* gp_ = Vtp + (size_t)d_ * ldv + key0_ + cc_ * 8; \
            asm volatile("global_load_dwordx4 %0, %1, off" : "=&v"(vst[set][i_]) : "v"(gp_)); } } while (0)
#define AT_WAITV(n) asm volatile("s_waitcnt vmcnt(%0)" :: "n"(n) : "memory")
    if (DEEP) { AT_GLOAD_ASM(0, 0); AT_GLOAD_ASM(1, 1); } else AT_GLOAD(0, 0);
#pragma unroll
    for (int g = 0; g < NQ; ++g)
#pragma unroll
        for (int s = 0; s < DQK / 16; ++s) asm volatile("" : "+v"(qf[g][s]));
    if (DEEP) AT_WAITV(NLD);
    AT_LSTORE(0, 0);
    __syncthreads();
    for (int t0 = 0; t0 < nt; t0 += (DEEP ? 2 : 1)) {
#pragma unroll
      for (int hf = 0; hf < (DEEP ? 2 : 1); ++hf) {
        const int t = t0 + hf;
        if (DEEP) { if (t + 2 < nt) AT_GLOAD_ASM(hf, t + 2); } else { if (t + 1 < nt) AT_GLOAD(0, t + 1); }
        const int key0 = kbeg + 64 * t;
        bool live = true;
        if (WIN) live = !(key0 + 63 < wq0 - 128 || key0 > wq0 + 32 * NQ - 1 + 128);
        if (live) {
            LAS unsigned char* B = lds + (t & 1) * BUF;
            f32x16 p[NQ][2];
            const float ci = 0.f;
            const f32x16 zero16 = {ci, ci, ci, ci, ci, ci, ci, ci, ci, ci, ci, ci, ci, ci, ci, ci};
            constexpr int NS = DQK / 16, NDB = DV / 32, NVF = 4 * NDB, NFR = (NVF > 8 ? NVF : 8);
            static_assert(NQ == 1 || NVF <= 8, "two row groups only with v dim 64");
            bf16x8 fr[NFR];
#define AT_SBAR() __builtin_amdgcn_sched_barrier(0)
#pragma unroll
            for (int s0 = 0; s0 < NS; s0 += 4) {
#pragma unroll
                for (int s2 = 0; s2 < 4; ++s2) if (s0 + s2 < NS) {
                    fr[2 * s2] = *(const LAS bf16x8*)(B + r32 * KROW + (16 * (s0 + s2) + 8 * hi) * 2);
                    fr[2 * s2 + 1] = *(const LAS bf16x8*)(B + (32 + r32) * KROW + (16 * (s0 + s2) + 8 * hi) * 2); }
                AT_SBAR();
#pragma unroll
                for (int s2 = 0; s2 < 4; ++s2) if (s0 + s2 < NS) {
#pragma unroll
                    for (int g = 0; g < NQ; ++g) {
                        p[g][0] = __builtin_amdgcn_mfma_f32_32x32x16_bf16(fr[2 * s2], qf[g][s0 + s2], (s0 + s2) == 0 ? zero16 : p[g][0], 0, 0, 0);
                        p[g][1] = __builtin_amdgcn_mfma_f32_32x32x16_bf16(fr[2 * s2 + 1], qf[g][s0 + s2], (s0 + s2) == 0 ? zero16 : p[g][1], 0, 0, 0); } }
                AT_SBAR();
            }
#define AT_VLOAD() do { _Pragma("unroll") for (int j_ = 0; j_ < 4; ++j_) _Pragma("unroll") for (int db_ = 0; db_ < NDB; ++db_) { fr[j_ * NDB + db_] = *(const LAS bf16x8*)(B + KT + (32 * db_ + r32) * VROW + 32 * j_ + 16 * hi); } AT_SBAR(); } while (0)
            if (NQ == 1) AT_VLOAD();
#pragma unroll
            for (int g = 0; g < NQ; ++g) {
                if (WIN) {
                    const int kb = key0 + 4 * hi - (qtok + 32 * g);
#pragma unroll
                    for (int r = 0; r < 16; ++r) { const int d0 = kb + (r & 3) + 8 * (r >> 2), d1 = d0 + 32;
                        if (d0 > 128 || d0 < -128) p[g][0][r] = -1e30f;
                        if (d1 > 128 || d1 < -128) p[g][1][r] = -1e30f; }
                }
                if constexpr (FIXM) {
                    f32x2 sum2 = {0.f, 0.f};
#pragma unroll
                    for (int h2 = 0; h2 < 2; ++h2)
#pragma unroll
                        for (int r = 0; r < 16; r += 2) { const f32x2 d2 = (f32x2){p[g][h2][r], p[g][h2][r + 1]} - (f32x2){sbound, sbound}; f32x2 e2; e2.x = __builtin_amdgcn_exp2f(d2.x); e2.y = __builtin_amdgcn_exp2f(d2.y); p[g][h2][r] = e2.x; p[g][h2][r + 1] = e2.y; sum2 += e2; }
                    l[g] += sum2.x + sum2.y;
                } else {
                if (!WIN) asm volatile("s_nop 15\n\ts_nop 7" : "+v"(p[g][0]), "+v"(p[g][1]));
                float mxa = max3f(p[g][0][0], p[g][1][0], p[g][0][1]), mxb = max3f(p[g][1][1], p[g][0][2], p[g][1][2]);
#pragma unroll
                for (int r = 3; r < 15; r += 2) { mxa = max3f(mxa, p[g][0][r], p[g][1][r]); mxb = max3f(mxb, p[g][0][r + 1], p[g][1][r + 1]); }
                float mx = max3f(mxa, mxb, max3f(p[g][0][15], p[g][1][15], p[g][0][15]));
                mx = swap32_max(mx);
                if (__any(mx > m[g] + THR)) {
                    const float mn = fmaxf(m[g], mx), alpha = __builtin_amdgcn_exp2f(m[g] - mn);
                    m[g] = mn; l[g] *= alpha;
#pragma unroll
                    for (int db = 0; db < NDB; ++db)
#pragma unroll
                        for (int r = 0; r < 16; ++r) o[g][db][r] *= alpha;
                }
                const float mr = m[g];
                f32x2 sum2 = {0.f, 0.f}; const f32x2 mr2 = {mr, mr};
#pragma unroll
                for (int h2 = 0; h2 < 2; ++h2)
#pragma unroll
                    for (int r = 0; r < 16; r += 2) { const f32x2 d2 = (f32x2){p[g][h2][r], p[g][h2][r + 1]} - mr2; f32x2 e2; e2.x = __builtin_amdgcn_exp2f(d2.x); e2.y = __builtin_amdgcn_exp2f(d2.y);
                        p[g][h2][r] = e2.x; p[g][h2][r + 1] = e2.y; sum2 += e2; }
                l[g] += sum2.x + sum2.y;
                }
            }
            if (FIXM) AT_SBAR();
            if (NQ != 1) AT_VLOAD();
#pragma unroll
            for (int j = 0; j < 4; ++j) {
                bf16x8 pb[NQ];
#pragma unroll
                for (int g = 0; g < NQ; ++g) { const int b2 = 8 * (j & 1); const f32x16& ps = p[g][j >> 1];
                    u32x4 pw; pw.x = cvtpk(ps[b2], ps[b2 + 1]); pw.y = cvtpk(ps[b2 + 2], ps[b2 + 3]); pw.z = cvtpk(ps[b2 + 4], ps[b2 + 5]); pw.w = cvtpk(ps[b2 + 6], ps[b2 + 7]);
                    pb[g] = __builtin_bit_cast(bf16x8, pw); }
#pragma unroll
                for (int db = 0; db < NDB; ++db)
#pragma unroll
                    for (int g = 0; g < NQ; ++g) o[g][db] = __builtin_amdgcn_mfma_f32_32x32x16_bf16(fr[j * NDB + db], pb[g], o[g][db], 0, 0, 0);
            }
            AT_SBAR();
#undef AT_SBAR
#undef AT_VLOAD
        }
        if (DEEP) { if (t + 2 < nt) AT_WAITV(NLD); else AT_WAITV(0); if (t + 1 < nt) AT_LSTORE(1 - hf, 1 - hf); } else { if (t + 1 < nt) AT_LSTORE(0, (t + 1) & 1); }
        __syncthreads();
      }
    }
#undef AT_GLOAD
#undef AT_GLOAD_ASM
#undef AT_WAITV
#undef AT_LSTORE
#pragma unroll
    for (int g = 0; g < NQ; ++g) { m_out[g] = m[g]; l_out[g] = l[g]; }
}
template <int DV>
__device__ __forceinline__ void store_o(const f32x16 (&o)[DV / 32], float scale, bf16_t* dst, int hi) {
#pragma unroll
    for (int db = 0; db < DV / 32; ++db)
#pragma unroll
        for (int rq = 0; rq < 4; ++rq) {
            u32x2 w; w.x = cvtpk(o[db][4 * rq] * scale, o[db][4 * rq + 1] * scale); w.y = cvtpk(o[db][4 * rq + 2] * scale, o[db][4 * rq + 3] * scale);
            *(u32x2*)(dst + 32 * db + 8 * rq + 4 * hi) = w;
        }
}

__device__ __forceinline__ void rownorm_rows(const float* x, const float* g, bf16_t* xn, int gw, int NGW, int lane) {
    const f32x4* gr = (const f32x4*)g + lane;
    f32x4 gg[4], nx[4];
#pragma unroll
    for (int j = 0; j < 4; ++j) { gg[j] = gr[64 * j]; nx[j] = ((const f32x4*)(x + (size_t)gw * DM) + lane)[64 * j]; }
    for (int r = gw; r < MG; r += NGW) {
        f32x4 v[4]; float s = 0.f;
#pragma unroll
        for (int j = 0; j < 4; ++j) { v[j] = nx[j]; s += (v[j].x * v[j].x + v[j].y * v[j].y) + (v[j].z * v[j].z + v[j].w * v[j].w); }
        if (r + NGW < MG) {
#pragma unroll
            for (int j = 0; j < 4; ++j) nx[j] = ((const f32x4*)(x + (size_t)(r + NGW) * DM) + lane)[64 * j]; }
        const float rs = 1.0f / sqrtf(wave_sum(s) * (1.f / DM) + EPS);
        unsigned long long* o8 = (unsigned long long*)(xn + (size_t)r * DM) + lane;
#pragma unroll
        for (int j = 0; j < 4; ++j) o8[64 * j] = (unsigned long long)pk2(v[j].x * rs * gg[j].x, v[j].y * rs * gg[j].y) | ((unsigned long long)pk2(v[j].z * rs * gg[j].z, v[j].w * rs * gg[j].w) << 32);
    }
}
__device__ __forceinline__ float wave_max(float v) {
#pragma unroll
    for (int o = 1; o < 64; o <<= 1) v = fmaxf(v, __shfl_xor(v, o));
    return __uint_as_float(__builtin_amdgcn_readfirstlane(__float_as_uint(v)));
}
template <int N> __device__ __forceinline__ void wave_sum_n(float (&v)[N]) {
#pragma unroll
    for (int o = 1; o < 64; o <<= 1)
#pragma unroll
        for (int i = 0; i < N; ++i) v[i] += __shfl_xor(v[i], o);
}
template <int MODE>
__device__ __forceinline__ void head64_norm_rope(bf16_t* p, const float* g, const float* tc, const float* ts, int pos, float oscale, int lane) {
    const float v = bf2f(p[lane]);
    const float rs = 1.0f / sqrtf(wave_sum(v * v) * (1.f / 64.f) + EPS);
    const float y = v * rs * g[lane];
    float out;
    if (MODE == 0) { const float pr = __shfl_xor(y, 32); const int i = lane & 31; const float c = tc[pos * 32 + i], s = ts[pos * 32 + i]; out = (lane < 32) ? (y * c - pr * s) : (pr * s + y * c); }
    else { const float pr = __shfl_xor(y, 16); const int i = lane & 15; const int pp = (lane < 32) ? (pos >> 6) : (pos & 63); const float c = tc[pp * 16 + i], s = ts[pp * 16 + i]; out = ((lane & 16) == 0) ? (y * c - pr * s) : (pr * s + y * c); }
    p[lane] = (bf16_t)f2bf(out * oscale);
}
__device__ __forceinline__ void head96_norm_rope(const bf16_t* src1, const bf16_t* src2, bf16_t* dst, const float* g, const float* tc, const float* ts, int pos, float oscale, int lane) {
    const float v1 = bf2f(src1[lane]); const float v2 = (lane < 32) ? bf2f(src2[lane]) : 0.f;
    const float rs = 1.0f / sqrtf(wave_sum(v1 * v1 + v2 * v2) * (1.f / 96.f) + EPS);
    const float y1 = v1 * rs * g[lane], y2 = v2 * rs * g[64 + (lane & 31)];
    const float pr = __shfl_xor(y2, 16); const int i = lane & 15; const float c = tc[pos * 16 + i], s = ts[pos * 16 + i];
    const float o2 = ((lane & 16) == 0) ? (y2 * c - pr * s) : (pr * s + y2 * c);
    dst[lane] = (bf16_t)f2bf(y1 * oscale);
    if (lane < 32) dst[64 + lane] = (bf16_t)f2bf(o2 * oscale);
}

__device__ __forceinline__ void titem_load(const float* W, int N, int k0, int n0, int lane, float (&wv)[32]) {
#pragma unroll
    for (int i = 0; i < 32; ++i) { const int kk = 2 * i + (lane >> 5); wv[i] = W[(size_t)(k0 + kk) * N + n0 + (lane & 31)]; }
}
__device__ __forceinline__ void titem_store(const float (&wv)[32], int K, bf16_t* WT, int drow, LAS float* scr, int k0, int lane) {
#pragma unroll
    for (int i = 0; i < 32; ++i) { const int kk = 2 * i + (lane >> 5); scr[kk * 33 + (lane & 31)] = wv[i]; }
    asm volatile("s_waitcnt lgkmcnt(0)" ::: "memory");
    const int c = lane & 7;
#pragma unroll
    for (int j = 0; j < 4; ++j) { const int n = (lane >> 3) + 8 * j; const LAS float* s = scr + (8 * c) * 33 + n;
        u32x4 o; o.x = pk2(s[0 * 33], s[1 * 33]); o.y = pk2(s[2 * 33], s[3 * 33]); o.z = pk2(s[4 * 33], s[5 * 33]); o.w = pk2(s[6 * 33], s[7 * 33]);
        *(u32x4*)(WT + (size_t)(drow + n) * K + k0 + 8 * c) = o; }
    asm volatile("s_waitcnt lgkmcnt(0)" ::: "memory");
}
__device__ __forceinline__ void convert_matrix(const float* W, int K, int N, bf16_t* WT, bf16_t* WT2, int mode, LAS float* scr, int gw, int NGW, int lane) {
    const int nblk = N / 32, nitems = (K / 64) * nblk;
    float wn[32];
    if (gw < nitems) titem_load(W, N, 64 * (gw / nblk), 32 * (gw % nblk), lane, wn);
    for (int it = gw; it < nitems; it += NGW) {
        const int kb = it / nblk, nb = it % nblk, n0 = 32 * nb; int drow = n0; bf16_t* dst = WT;
        if (mode == 1) { if (n0 < DFF) drow = 256 * (n0 / 128) + (n0 % 128); else { const int u = n0 - DFF; drow = 256 * (u / 128) + 128 + (u % 128); } }
        else if (mode == 2) { const int h = n0 / 128, w = n0 % 128; if (w < 64) drow = h * 64 + w; else { dst = WT2; drow = h * 64 + w - 64; } }
        float wc[32];
#pragma unroll
        for (int i = 0; i < 32; ++i) wc[i] = wn[i];
        const int it2 = it + NGW;
        if (it2 < nitems) titem_load(W, N, 64 * (it2 / nblk), 32 * (it2 % nblk), lane, wn);
        titem_store(wc, K, dst, drow, scr, 64 * kb, lane);
    }
}

__constant__ float INV32[32] = {1.0f, 0.7498942613601685f, 0.5623413324356079f, 0.4216965138912201f, 0.3162277638912201f, 0.23713737726211548f, 0.17782793939113617f, 0.133352130651474f, 0.10000000149011612f, 0.07498941570520401f, 0.05623413249850273f, 0.04216965287923813f, 0.03162277489900589f, 0.023713737726211548f, 0.017782794311642647f, 0.01333521492779255f, 0.009999999776482582f, 0.007498941849917173f, 0.005623413249850273f, 0.0042169648222625256f, 0.003162277629598975f, 0.00237137358635664f, 0.0017782794311642647f, 0.0013335214462131262f, 0.0010000000474974513f, 0.0007498942431993783f, 0.000562341301701963f, 0.0004216965171508491f, 0.0003162277571391314f, 0.00023713737027719617f, 0.00017782794020604342f, 0.0001333521504420787f};
__constant__ float INV16[16] = {1.0f, 0.5623413324356079f, 0.3162277638912201f, 0.17782793939113617f, 0.10000000149011612f, 0.05623413249850273f, 0.03162277489900589f, 0.017782794311642647f, 0.009999999776482582f, 0.005623413249850273f, 0.003162277629598975f, 0.0017782794311642647f, 0.0010000000474974513f, 0.000562341301701963f, 0.0003162277571391314f, 0.00017782794020604342f};
struct Args { const float* in[29]; float* out; unsigned char* ws; };

__global__ void __launch_bounds__(512) hybrid_fwd(Args a) {
    extern __shared__ __attribute__((aligned(16))) unsigned char lds_raw[];
    LAS unsigned char* lds = (LAS unsigned char*)lds_raw;
    cg::grid_group grid = cg::this_grid();
    const int tid = threadIdx.x, lane = tid & 63, wid = __builtin_amdgcn_readfirstlane(tid >> 6);
    const int G = gridDim.x, gw = blockIdx.x * 8 + wid, NGW = G * 8;
#define ctl ((unsigned*)(a.ws + WS_CTL))
#define T32C ((float*)(a.ws + WS_T32C))
#define T32S ((float*)(a.ws + WS_T32S))
#define T16C ((float*)(a.ws + WS_T16C))
#define T16S ((float*)(a.ws + WS_T16S))
#define XN ((bf16_t*)(a.ws + WS_XN))
#define HB ((bf16_t*)(a.ws + WS_H))
#define Z ((bf16_t*)(a.ws + WS_Z))
#define W_EV_IN ((bf16_t*)(a.ws + WS_EV_IN))
#define W_UQ ((bf16_t*)(a.ws + WS_UQ))
#define W_UK ((bf16_t*)(a.ws + WS_UK))
#define W_UV ((bf16_t*)(a.ws + WS_UV))
#define W_EV_OUT ((bf16_t*)(a.ws + WS_EV_OUT))
#define W_OD_IN ((bf16_t*)(a.ws + WS_OD_IN))
#define W_OD_OUT ((bf16_t*)(a.ws + WS_OD_OUT))
#define VTA ((bf16_t*)(a.ws + WS_VTA))
#define QB ((bf16_t*)(a.ws + WS_QB))
#define KNOPE ((bf16_t*)(a.ws + WS_KNOPE))
#define KB ((bf16_t*)(a.ws + WS_KB))
#define VTB ((bf16_t*)(a.ws + WS_VTB))
#define VTC ((bf16_t*)(a.ws + WS_VTC))
#define VTD ((bf16_t*)(a.ws + WS_VTD))
#define O1 ((float*)(a.ws + WS_O1))
#define XBUF ((unsigned*)(a.ws + WS_CTL + 512 * 1024))
    volatile LAS unsigned* misc = (volatile LAS unsigned*)(lds + MISC_OFF);
    if (threadIdx.x < 16) misc[threadIdx.x] = 0u;
    __syncthreads();
    const XcdBarrier xbar = xcd_barrier_post(ctl + 1024, misc + 8);

    {
        LAS float* scr = (LAS float*)(lds + wid * 16384);
        for (int f = 0; f < 4; ++f) {
            const int l = f >> 1, which = f & 1;
            convert_matrix((which ? a.in[6] : a.in[3]) + (size_t)l * DM * 2 * DFF, DM, 2 * DFF, (bf16_t*)(a.ws + WS_FFN_IN + f * FFN_IN_BYTES), nullptr, 1, scr, gw, NGW, lane);
            convert_matrix((which ? a.in[7] : a.in[4]) + (size_t)l * DFF * DM, DFF, DM, (bf16_t*)(a.ws + WS_FFN_OUT + f * FFN_OUT_BYTES), nullptr, 0, scr, gw, NGW, lane);
        }
        convert_matrix(a.in[9], DM, EVN_REAL, W_EV_IN, nullptr, 0, scr, gw, NGW, lane);
        convert_matrix(a.in[14], 512, 768, W_UQ, nullptr, 0, scr, gw, NGW, lane);
        convert_matrix(a.in[16], 256, 1024, W_UK, W_UV, 2, scr, gw, NGW, lane);
        convert_matrix(a.in[19], DM, DM, W_EV_OUT, nullptr, 0, scr, gw, NGW, lane);
        convert_matrix(a.in[21], DM, ODN, W_OD_IN, nullptr, 0, scr, gw, NGW, lane);
        convert_matrix(a.in[28], DM, DM, W_OD_OUT, nullptr, 0, scr, gw, NGW, lane);
        { const int gt = blockIdx.x * 512 + tid, NT = G * 512; const u32x4 z4 = (u32x4){0u, 0u, 0u, 0u};
          u32x4* p1 = (u32x4*)(W_EV_IN + (size_t)EVN_REAL * 1024); for (int i = gt; i < (EVN - EVN_REAL) * 1024 / 8; i += NT) p1[i] = z4;
          u32x4* p2 = (u32x4*)(W_OD_IN + (size_t)ODN * 1024); for (int i = gt; i < (ODN_PAD - ODN) * 1024 / 8; i += NT) p2[i] = z4;
          for (int e = gt; e < 8192 * 32; e += NT) { const int p = e >> 5, i = e & 31; const float ang = (float)p * INV32[i]; const double rev = (double)ang * 0.15915494309189535; const float fr = (float)(rev - __builtin_rint(rev));
              T32C[e] = __builtin_amdgcn_cosf(fr); T32S[e] = __builtin_amdgcn_sinf(fr); }
          for (int e = gt; e < 8192 * 16; e += NT) { const int p = e >> 4, i = e & 15; const float ang = (float)p * INV16[i]; const double rev = (double)ang * 0.15915494309189535; const float fr = (float)(rev - __builtin_rint(rev));
              T16C[e] = __builtin_amdgcn_cosf(fr); T16S[e] = __builtin_amdgcn_sinf(fr); } }
    }
    rownorm_rows(a.in[0], a.in[2], XN, gw, NGW, lane);
    grid.sync();

    for (int p = 0; p < 56; ++p) {
        const int st = p % 14, l = (p / 14) & 1, g = p / 28;
        const bool even = (l == 0);
        if ((!even && (st == 6 || st == 7)) || st == 9 || st == 3 || st == 11 || (st == 0 && (l == 1 || g == 0))) continue;
        const int S = g ? 4096 : 8192, nqb = S / 256;
        int tidp = threadIdx.x; asm volatile("" : "+v"(tidp));
        const int tid = tidp, lane = tid & 63, wid = __builtin_amdgcn_readfirstlane(tid >> 6), gw = blockIdx.x * 8 + wid;
        float* xo = a.out + (size_t)g * MG * DM;
        switch (st) {
        case 0: case 3: case 11: {
            const float* xsrc = (l == 0 && st == 0) ? (g ? a.in[1] : a.in[0]) : xo;
            const float* gn = (st == 0) ? a.in[2] + l * DM : (st == 11) ? a.in[5] + l * DM : (even ? a.in[8] : a.in[20]);
            rownorm_rows(xsrc, gn, XN, gw, NGW, lane);
        } break;
        case 1: case 12: {
            const int f = (st == 12);
            pg8::Gemm gm{XN, (const bf16_t*)(a.ws + WS_FFN_IN + (size_t)(l * 2 + f) * FFN_IN_BYTES), MG, 2 * DFF, DM, DM, DM}; pg8::StaticOrder So; So.init(MG, 2 * DFF, G, (int)blockIdx.x);
            pg8::EpiSwiglu E{HB, DFF}; pg8::gemm_phase<pg8::EpiSwiglu, pg8::StaticOrder, true, true>(lds, gm, So, E);
        } break;
        case 2: case 13: {
            const int f = (st == 13);
            const float* xsrc = (l == 0 && f == 0) ? (g ? a.in[1] : a.in[0]) : xo;
            const float* gnext = (f == 0) ? (even ? a.in[8] : a.in[20]) : (a.in[2] + DM);
            pg8::Gemm gm{HB, (const bf16_t*)(a.ws + WS_FFN_OUT + (size_t)(l * 2 + f) * FFN_OUT_BYTES), MG, DM, DFF, DFF, DFF}; pg8::StaticOrder So; So.init(MG, DM, G, (int)blockIdx.x);
            pg8::EpiResidNorm E{xsrc, xo, DM, 0.5f, gnext, XN, XBUF, ctl + 8192 + ((g * 2 + l) * 3 + (f ? 2 : 0)) * 1024, (l == 1 && f == 1) ? 0 : 1}; pg8::gemm_phase<pg8::EpiResidNorm, pg8::StaticOrder, false, true>(lds, gm, So, E);
        } break;
        case 4: {
            if (even) {
                { pg8::Gemm gm{XN, W_EV_IN, MG, EVN, DM, DM, DM}; pg8::StaticOrder So; So.init(MG, EVN, G, (int)blockIdx.x); pg8::EpiStore E{Z, EVN}; pg8::gemm_phase<pg8::EpiStore, pg8::StaticOrder, true, true>(lds, gm, So, E); }
                { pg8::Gemm gm{W_EV_IN + (size_t)640 * DM, XN, 256, MG, DM, DM, DM}; pg8::StaticOrder So; So.init(256, MG, G, (int)((blockIdx.x + 64) & 255)); pg8::EpiStore E{VTA, MG}; pg8::gemm_phase<pg8::EpiStore, pg8::StaticOrder, true, true>(lds, gm, So, E); }
            } else {
                { pg8::Gemm gm{XN, W_OD_IN, MG, ODN, DM, DM, DM}; pg8::StaticOrder So; So.init(MG, ODN, G, (int)blockIdx.x); pg8::EpiStore E{Z, ODN}; pg8::gemm_phase<pg8::EpiStore, pg8::StaticOrder, true, true>(lds, gm, So, E); }
                { pg8::Gemm gm{W_OD_IN + (size_t)1024 * DM, XN, 512, MG, DM, DM, DM}; pg8::StaticOrder So; So.init(512, MG, G, (int)((blockIdx.x + 192) & 255)); pg8::EpiStore E{VTC, MG}; pg8::gemm_phase<pg8::EpiStore, pg8::StaticOrder, true, true>(lds, gm, So, E); }
                { pg8::Gemm gm{W_OD_IN + (size_t)2176 * DM, XN, 256, MG, DM, DM, DM}; pg8::StaticOrder So; So.init(256, MG, G, (int)((blockIdx.x + 64) & 255)); pg8::EpiStore E{VTD, MG}; pg8::gemm_phase<pg8::EpiStore, pg8::StaticOrder, true, true>(lds, gm, So, E); }
            }
        } break;
        case 5: {
            if (even) {
                const float gq = a.in[10][lane], gk = a.in[11][lane];
                const f32x4 gc0 = *(const f32x4*)(a.in[13] + lane * 8), gc1 = *(const f32x4*)(a.in[13] + lane * 8 + 4), gv0 = *(const f32x4*)(a.in[15] + lane * 4);
                bf16_t nx[10]; u32x4 nq; u32x2 nk;
                { const bf16_t* z0 = Z + (size_t)gw * EVN;
#pragma unroll
                  for (int hh = 0; hh < 10; ++hh) nx[hh] = z0[hh * 64 + lane];
                  nq = *(const u32x4*)(z0 + 768 + lane * 8); nk = *(const u32x2*)(z0 + 1280 + lane * 4); }
                for (int r = gw; r < MG; r += NGW) { bf16_t* zr = Z + (size_t)r * EVN; const int pos = r & (S - 1);
                    float v[10], ss[12];
#pragma unroll
                    for (int hh = 0; hh < 10; ++hh) v[hh] = bf2f(nx[hh]);
                    const u32x4 rq = nq; const u32x2 rk = nk;
                    if (r + NGW < MG) { const bf16_t* z1 = zr + (size_t)NGW * EVN;
#pragma unroll
                        for (int hh = 0; hh < 10; ++hh) nx[hh] = z1[hh * 64 + lane];
                        nq = *(const u32x4*)(z1 + 768 + lane * 8); nk = *(const u32x2*)(z1 + 1280 + lane * 4); }
                    const float c = T32C[pos * 32 + (lane & 31)], sn = T32S[pos * 32 + (lane & 31)];
                    float cq[8], ck[4];
                    cq[0] = __uint_as_float(rq.x << 16); cq[1] = __uint_as_float(rq.x & 0xffff0000u); cq[2] = __uint_as_float(rq.y << 16); cq[3] = __uint_as_float(rq.y & 0xffff0000u);
                    cq[4] = __uint_as_float(rq.z << 16); cq[5] = __uint_as_float(rq.z & 0xffff0000u); cq[6] = __uint_as_float(rq.w << 16); cq[7] = __uint_as_float(rq.w & 0xffff0000u);
                    ck[0] = __uint_as_float(rk.x << 16); ck[1] = __uint_as_float(rk.x & 0xffff0000u); ck[2] = __uint_as_float(rk.y << 16); ck[3] = __uint_as_float(rk.y & 0xffff0000u);
#pragma unroll
                    for (int hh = 0; hh < 10; ++hh) ss[hh] = v[hh] * v[hh];
                    ss[10] = ((cq[0] * cq[0] + cq[1] * cq[1]) + (cq[2] * cq[2] + cq[3] * cq[3])) + ((cq[4] * cq[4] + cq[5] * cq[5]) + (cq[6] * cq[6] + cq[7] * cq[7]));
                    ss[11] = (ck[0] * ck[0] + ck[1] * ck[1]) + (ck[2] * ck[2] + ck[3] * ck[3]);
                    wave_sum_n<12>(ss);
                    float y[10], pr[10];
#pragma unroll
                    for (int hh = 0; hh < 10; ++hh) { y[hh] = v[hh] * (1.0f / sqrtf(ss[hh] * (1.f / 64.f) + EPS)) * (hh < 8 ? gq : gk); pr[hh] = __shfl_xor(y[hh], 32); }
#pragma unroll
                    for (int hh = 0; hh < 10; ++hh) { const float o = (lane < 32) ? (y[hh] * c - pr[hh] * sn) : (pr[hh] * sn + y[hh] * c); zr[hh * 64 + lane] = (bf16_t)f2bf(o * (hh < 8 ? 0.125f * LOG2E : 1.0f)); }
                    { const float rs = 1.0f / sqrtf(ss[10] * (1.f / 512.f) + EPS);
                      u32x4 w; w.x = pk2(cq[0] * rs * gc0.x, cq[1] * rs * gc0.y); w.y = pk2(cq[2] * rs * gc0.z, cq[3] * rs * gc0.w); w.z = pk2(cq[4] * rs * gc1.x, cq[5] * rs * gc1.y); w.w = pk2(cq[6] * rs * gc1.z, cq[7] * rs * gc1.w);
                      *(u32x4*)(zr + 768 + lane * 8) = w; }
                    { const float rs = 1.0f / sqrtf(ss[11] * (1.f / 256.f) + EPS);
                      u32x2 w; w.x = pk2(ck[0] * rs * gv0.x, ck[1] * rs * gv0.y); w.y = pk2(ck[2] * rs * gv0.z, ck[3] * rs * gv0.w);
                      *(u32x2*)(zr + 1280 + lane * 4) = w; } }
            } else {
                const float gcq = a.in[22][lane], gck = a.in[23][lane], gdq = a.in[26][lane], gdk = a.in[27][lane];
                bf16_t nx[26];
                { const bf16_t* z0 = Z + (size_t)gw * ODN;
#pragma unroll
                  for (int hh = 0; hh < 16; ++hh) nx[hh] = z0[hh * 64 + lane];
#pragma unroll
                  for (int hh = 0; hh < 10; ++hh) nx[16 + hh] = z0[1536 + hh * 64 + lane]; }
                for (int r = gw; r < MG; r += NGW) { bf16_t* zr = Z + (size_t)r * ODN; const int pos = r & (S - 1);
                    float v[26], ss[26];
#pragma unroll
                    for (int hh = 0; hh < 26; ++hh) v[hh] = bf2f(nx[hh]);
                    if (r + NGW < MG) { const bf16_t* z1 = zr + (size_t)NGW * ODN;
#pragma unroll
                        for (int hh = 0; hh < 16; ++hh) nx[hh] = z1[hh * 64 + lane];
#pragma unroll
                        for (int hh = 0; hh < 10; ++hh) nx[16 + hh] = z1[1536 + hh * 64 + lane]; }
                    const float c = T32C[pos * 32 + (lane & 31)], sn = T32S[pos * 32 + (lane & 31)];
                    const int pp = (lane < 32) ? (pos >> 6) : (pos & 63); const float c2 = T16C[pp * 16 + (lane & 15)], s2 = T16S[pp * 16 + (lane & 15)];
#pragma unroll
                    for (int hh = 0; hh < 26; ++hh) ss[hh] = v[hh] * v[hh];
                    wave_sum_n<26>(ss);
#pragma unroll
                    for (int hh = 0; hh < 16; ++hh) { const float y = v[hh] * (1.0f / sqrtf(ss[hh] * (1.f / 64.f) + EPS)) * (hh < 8 ? gcq : gck); const float pr = __shfl_xor(y, 32);
                        const float o = (lane < 32) ? (y * c - pr * sn) : (pr * sn + y * c); zr[hh * 64 + lane] = (bf16_t)f2bf(o * (hh < 8 ? 0.125f * LOG2E : 1.0f)); }
#pragma unroll
                    for (int hh = 0; hh < 10; ++hh) { const float y = v[16 + hh] * (1.0f / sqrtf(ss[16 + hh] * (1.f / 64.f) + EPS)) * (hh < 8 ? gdq : gdk); const float pr = __shfl_xor(y, 16);
                        const float o = ((lane & 16) == 0) ? (y * c2 - pr * s2) : (pr * s2 + y * c2); zr[1536 + hh * 64 + lane] = (bf16_t)f2bf(o * (hh < 8 ? 0.125f * LOG2E : 1.0f)); } }
            }
        } break;
        case 6: {
            { pg8::Gemm gm{Z + 768, W_UQ, MG, 768, 512, EVN, 512}; pg8::StaticOrder So; So.init(MG, 768, G, (int)blockIdx.x); pg8::EpiStore E{QB, 768}; pg8::gemm_phase<pg8::EpiStore, pg8::StaticOrder, true, true>(lds, gm, So, E); }
            { pg8::Gemm gm{Z + 1280, W_UK, MG, 512, 256, EVN, 256}; pg8::StaticOrder So; So.init(MG, 512, G, (int)((blockIdx.x + 64) & 255)); pg8::EpiStore E{KNOPE, 512}; pg8::gemm_phase<pg8::EpiStore, pg8::StaticOrder, true, true>(lds, gm, So, E); }
            { pg8::Gemm gm{W_UV, Z + 1280, 512, MG, 256, 256, EVN}; pg8::StaticOrder So; So.init(512, MG, G, (int)((blockIdx.x + 192) & 255)); pg8::EpiStore E{VTB, MG}; pg8::gemm_phase<pg8::EpiStore, pg8::StaticOrder, true, true>(lds, gm, So, E); }
        } break;
        case 7: {
            const float gq1 = a.in[17][lane], gq2 = a.in[17][64 + (lane & 31)], gk1 = a.in[18][lane], gk2 = a.in[18][64 + (lane & 31)]; const float qs = 0.10206207261596577f * LOG2E;
            bf16_t n1[8], n2[8], n3[8], nr;
            { const bf16_t* q0 = QB + (size_t)gw * 768; const bf16_t* k0 = KNOPE + (size_t)gw * 512; nr = Z[(size_t)gw * EVN + 1536 + (lane & 31)];
#pragma unroll
              for (int h = 0; h < 8; ++h) { n1[h] = q0[h * 96 + lane]; n2[h] = q0[h * 96 + 64 + (lane & 31)]; n3[h] = k0[h * 64 + lane]; } }
            for (int r = gw; r < MG; r += NGW) { const int pos = r & (S - 1);
                bf16_t* q = QB + (size_t)r * 768; bf16_t* ko = KB + (size_t)r * 768;
                float q1[8], q2[8], k1[8], ss[16];
                const float kr = (lane < 32) ? bf2f(nr) : 0.f;
#pragma unroll
                for (int h = 0; h < 8; ++h) { q1[h] = bf2f(n1[h]); q2[h] = (lane < 32) ? bf2f(n2[h]) : 0.f; k1[h] = bf2f(n3[h]); }
                if (r + NGW < MG) { const bf16_t* q0 = q + (size_t)NGW * 768; const bf16_t* k0 = KNOPE + (size_t)(r + NGW) * 512; nr = Z[(size_t)(r + NGW) * EVN + 1536 + (lane & 31)];
#pragma unroll
                    for (int h = 0; h < 8; ++h) { n1[h] = q0[h * 96 + lane]; n2[h] = q0[h * 96 + 64 + (lane & 31)]; n3[h] = k0[h * 64 + lane]; } }
                const float c = T16C[pos * 16 + (lane & 15)], sn = T16S[pos * 16 + (lane & 15)];
#pragma unroll
                for (int h = 0; h < 8; ++h) { ss[h] = q1[h] * q1[h] + q2[h] * q2[h]; ss[8 + h] = k1[h] * k1[h] + kr * kr; }
                wave_sum_n<16>(ss);
#pragma unroll
                for (int h = 0; h < 8; ++h) {
                    { const float rs = 1.0f / sqrtf(ss[h] * (1.f / 96.f) + EPS); const float y1 = q1[h] * rs * gq1, y2 = q2[h] * rs * gq2; const float pr = __shfl_xor(y2, 16);
                      const float o2 = ((lane & 16) == 0) ? (y2 * c - pr * sn) : (pr * sn + y2 * c);
                      q[h * 96 + lane] = (bf16_t)f2bf(y1 * qs); if (lane < 32) q[h * 96 + 64 + lane] = (bf16_t)f2bf(o2 * qs); }
                    { const float rs = 1.0f / sqrtf(ss[8 + h] * (1.f / 96.f) + EPS); const float y1 = k1[h] * rs * gk1, y2 = kr * rs * gk2; const float pr = __shfl_xor(y2, 16);
                      const float o2 = ((lane & 16) == 0) ? (y2 * c - pr * sn) : (pr * sn + y2 * c);
                      ko[h * 96 + lane] = (bf16_t)f2bf(y1); if (lane < 32) ko[h * 96 + 64 + lane] = (bf16_t)f2bf(o2); } } }
        } break;
        case 8: {
#ifndef ATT_REP
#define ATT_REP 1
#endif
                    for (int rep = 0; rep < ATT_REP; ++rep) {
                    unsigned* qctr = ctl + 64 * (g * 2 + l + 4 * rep);
                    float sb_mla = 0.f, sb_a = 0.f, sb_c = 0.f, sb_d = 0.f;
                    if (even) { sb_a = 1.02f * 8.0f * LOG2E * wave_max(fabsf(a.in[10][lane])) * wave_max(fabsf(a.in[11][lane]));
                                sb_mla = 1.02f * 9.797958971f * LOG2E * wave_max(fmaxf(fabsf(a.in[17][lane]), fabsf(a.in[17][64 + (lane & 31)]))) * wave_max(fmaxf(fabsf(a.in[18][lane]), fabsf(a.in[18][64 + (lane & 31)]))); }
                    else { sb_c = 1.02f * 8.0f * LOG2E * wave_max(fabsf(a.in[22][lane])) * wave_max(fabsf(a.in[23][lane]));
                           sb_d = 1.02f * 8.0f * LOG2E * wave_max(fabsf(a.in[26][lane])) * wave_max(fabsf(a.in[27][lane])); }
                    const int ntot = even ? 1024 : 768;
                    for (;;) {
                        __syncthreads();
                        if (tid == 0) misc[0] = atomicAdd(qctr, 1u);
                        __syncthreads();
                        const int u = (int)misc[0];
                        if (u >= ntot) break;
                        const int r32 = lane & 31, hi = lane >> 5;
                        const int nqb2 = S / 512;
                        if (even) {
                            if (u < 512) {
                                const int qb = u % nqb, h = (u / nqb) & 7, seq = u / (nqb * 8); const int q0 = seq * S + qb * 256, qtok = q0 + wid * 32 + r32;
                                f32x16 o[1][2]; float m[1], lp[1];
                                if (sb_mla < 48.f) attn_core<96, 64, false, 1, true, true>(lds, QB + (size_t)qtok * 768 + h * 96, 768, KB + h * 96, 768, VTB + (size_t)(h * 64) * MG, MG, seq * S, seq * S + S, qtok, o, m, lp, sb_mla);
                                else attn_core<96, 64, false, 1, true, false>(lds, QB + (size_t)qtok * 768 + h * 96, 768, KB + h * 96, 768, VTB + (size_t)(h * 64) * MG, MG, seq * S, seq * S + S, qtok, o, m, lp);
                                store_o<64>(o[0], 1.0f / swap32_sum(lp[0]), XN + (size_t)qtok * DM + 512 + h * 64, hi);
                            } else {
                                const int v = u - 512; const int qb = v % nqb, h = (v / nqb) & 7, seq = v / (nqb * 8); const int q0 = seq * S + qb * 256, qtok = q0 + wid * 32 + r32;
                                const int kbeg = (qb == 0) ? q0 : q0 - 128, kend = (qb == nqb - 1) ? q0 + 256 : q0 + 384;
                                f32x16 o[1][2]; float m[1], lp[1];
                                attn_core<64, 64, true, 1, false, false>(lds, Z + (size_t)qtok * EVN + h * 64, EVN, Z + 512 + (h >> 2) * 64, EVN, VTA + (size_t)((h >> 2) * 64) * MG, MG, kbeg, kend, qtok, o, m, lp, sb_a);
                                const float lt = swap32_sum(lp[0]) + __builtin_amdgcn_exp2f(a.in[12][h] * LOG2E - m[0]);
                                store_o<64>(o[0], 1.0f / lt, XN + (size_t)qtok * DM + h * 64, hi);
                            }
                        } else {
                            if (u >= 256) {
                                const int v = u - 256; const int qb = v % nqb, h = (v / nqb) & 7, seq = v / (nqb * 8); const int q0 = seq * S + qb * 256, qtok = q0 + wid * 32 + r32;
                                f32x16 o[1][2]; float m[1], lp[1];
                                if (sb_d < 48.f) attn_core<64, 64, false, 1, true, true>(lds, Z + (size_t)qtok * ODN + 1536 + h * 64, ODN, Z + 2048 + (h >> 2) * 64, ODN, VTD + (size_t)((h >> 2) * 64) * MG, MG, seq * S, seq * S + S, qtok, o, m, lp, sb_d);
                                else attn_core<64, 64, false, 1, true, false>(lds, Z + (size_t)qtok * ODN + 1536 + h * 64, ODN, Z + 2048 + (h >> 2) * 64, ODN, VTD + (size_t)((h >> 2) * 64) * MG, MG, seq * S, seq * S + S, qtok, o, m, lp);
                                store_o<64>(o[0], 1.0f / swap32_sum(lp[0]), XN + (size_t)qtok * DM + 512 + h * 64, hi);
                            } else {
                                const int qb = u % nqb, h = (u / nqb) & 3, seq = u / (nqb * 4); const int q0 = seq * S + qb * 256, qtok = q0 + wid * 32 + r32;
#pragma unroll 1
                                for (int c = 0; c < 2; ++c) {
                                    f32x16 o[1][4]; float m[1], lp[1];
                                    attn_core<64, 128, false, 1, true, false>(lds, Z + (size_t)qtok * ODN + (2 * h + c) * 64, ODN, Z + 512 + (2 * h + c) * 64, ODN, VTC + (size_t)(h * 128) * MG, MG, seq * S, seq * S + S, qtok, o, m, lp, sb_c);
                                    int tl = threadIdx.x; asm volatile("" : "+v"(tl)); float* stash = O1 + ((size_t)blockIdx.x * 8 + (tl >> 6)) * 4096 + (tl & 63);
                                    if (c == 0) { const float inv = 1.0f / swap32_sum(lp[0]);
#pragma unroll
                                        for (int db = 0; db < 4; ++db)
#pragma unroll
                                            for (int r = 0; r < 16; ++r) stash[(db * 16 + r) * 64] = o[0][db][r] * inv;
                                        asm volatile("s_waitcnt vmcnt(0)" ::: "memory");
                                    } else {
                                        const float* lpm = a.in[24];
                                        const float lam = __expf(wave_sum(lpm[tl & 63] * lpm[64 + (tl & 63)])) - __expf(wave_sum(lpm[128 + (tl & 63)] * lpm[192 + (tl & 63)])) + LAM_INIT;
                                        const float inv2 = lam / swap32_sum(lp[0]); float ss = 0.f;
#pragma unroll
                                        for (int db = 0; db < 4; ++db) {
#pragma unroll
                                            for (int r = 0; r < 16; ++r) { const float d = stash[(db * 16 + r) * 64] - o[0][db][r] * inv2; o[0][db][r] = d; ss += d * d; }
                                            asm volatile("" ::: "memory"); }
                                        const float rs = (1.0f - LAM_INIT) / sqrtf(swap32_sum(ss) * (1.f / 128.f) + EPS);
                                        const float* gon = a.in[25];
                                        bf16_t* dsto = XN + (size_t)qtok * DM + h * 128;
#pragma unroll
                                        for (int db = 0; db < 4; ++db) {
#pragma unroll
                                            for (int rq = 0; rq < 4; ++rq) { const f32x4 g4 = *(const f32x4*)(gon + 32 * db + 8 * rq + 4 * hi);
                                                u32x2 w; w.x = cvtpk(o[0][db][4 * rq] * rs * g4.x, o[0][db][4 * rq + 1] * rs * g4.y); w.y = cvtpk(o[0][db][4 * rq + 2] * rs * g4.z, o[0][db][4 * rq + 3] * rs * g4.w);
                                                *(u32x2*)(dsto + 32 * db + 8 * rq + 4 * hi) = w; }
                                            asm volatile("" ::: "memory"); }
                                    }
                                }
                            }
                        }
                    }
                    }
        } break;
        case 9: {
            const float* lpm = a.in[24]; const float* gon = a.in[25];
            const float lam = __expf(wave_sum(lpm[lane] * lpm[64 + lane])) - __expf(wave_sum(lpm[128 + lane] * lpm[192 + lane])) + LAM_INIT;
            for (int r = gw; r < MG; r += NGW) {
#pragma unroll
                for (int h = 0; h < 4; ++h) { const float* p1 = O1 + ((size_t)r * 8 + 2 * h) * 128 + 2 * lane; const float d0 = p1[0] - lam * p1[128], d1 = p1[1] - lam * p1[129];
                    const float rs = (1.0f - LAM_INIT) / sqrtf(wave_sum(d0 * d0 + d1 * d1) * (1.f / 128.f) + EPS);
                    *(unsigned*)(XN + (size_t)r * DM + h * 128 + 2 * lane) = pk2(d0 * rs * gon[2 * lane], d1 * rs * gon[2 * lane + 1]); } }
        } break;
        case 10: {
            pg8::Gemm gm{XN, even ? W_EV_OUT : W_OD_OUT, MG, DM, DM, DM, DM}; pg8::StaticOrder So; So.init(MG, DM, G, (int)blockIdx.x);
            pg8::EpiResidNorm E{xo, xo, DM, 1.0f, a.in[5] + l * DM, XN, XBUF, ctl + 8192 + ((g * 2 + l) * 3 + 1) * 1024, 1}; pg8::gemm_phase<pg8::EpiResidNorm, pg8::StaticOrder, false, true>(lds, gm, So, E);
        } break;
        }
#ifndef SYNC_REP
#define SYNC_REP 1
#endif
        for (int rep = 0; rep < SYNC_REP; ++rep) xcd_barrier(xbar);
    }
}

extern "C" void kernel_launch(void* const* d_in, const int* in_sizes, int n_in, void* d_out, int out_size, void* d_ws, size_t ws_size, hipStream_t stream) {
    static int grid = 0;
    if (grid == 0) {
        if (n_in != 29 || ws_size < WS_END) { fprintf(stderr, "kernel_launch: unexpected inputs (n_in %d, ws %zu)\n", n_in, ws_size); grid = -1; return; }
        int dev = 0, cus = 0, per_cu = 0;
        hipGetDevice(&dev); hipDeviceGetAttribute(&cus, hipDeviceAttributeMultiprocessorCount, dev);
        hipFuncSetAttribute((const void*)hybrid_fwd, hipFuncAttributeMaxDynamicSharedMemorySize, LDS_BYTES);
        hipOccupancyMaxActiveBlocksPerMultiprocessor(&per_cu, (const void*)hybrid_fwd, 512, LDS_BYTES);
        if (per_cu < 1) per_cu = 1;
        grid = cus * (per_cu > 1 ? 1 : per_cu);
        if (grid != 256) { fprintf(stderr, "kernel_launch: this kernel needs exactly 256 workgroups (one per CU); got %d\n", grid); grid = -1; return; }
        (void)hipGetLastError();
    }
    if (grid < 0) return;
    hipMemsetAsync((char*)d_ws + WS_CTL, 0, 131072, stream);
    Args a{};
    for (int i = 0; i < 29; ++i) a.in[i] = (const float*)d_in[i];
    a.out = (float*)d_out; a.ws = (unsigned char*)d_ws;
    for (int i = 0; i < 32; ++i) INV32[i] = powf(10000.0f, -((float)(2 * i) / 64.0f));
    for (int i = 0; i < 16; ++i) INV16[i] = powf(10000.0f, -((float)(2 * i) / 32.0f));
    void* args[] = {&a};
    hipError_t e = hipLaunchCooperativeKernel((const void*)hybrid_fwd, dim3(grid), dim3(512), args, LDS_BYTES, stream);
    if (e != hipSuccess) fprintf(stderr, "cooperative launch failed: %s (grid %d)\n", hipGetErrorString(e), grid);
}
```
